# Optimizing an MI355X kernel written in HIP

```python
import math
import jax, jax.numpy as jnp
from jax import lax
import numpy as np

D_MODEL = 2048
BATCH = 2
SEQ = 8192
DEPTH = 1

SSM_WIDTH = D_MODEL // 2
SSM_GROUP = 16
SSM_GROUPS = SSM_WIDTH // SSM_GROUP
SSM_STATE = 64
ATTN_HEAD_DIM = 128
ATTN_WIDTH = D_MODEL - SSM_WIDTH
ATTN_HEADS = ATTN_WIDTH // ATTN_HEAD_DIM
Q_BLOCK = 128
IN_COLS = SSM_WIDTH + 3 * ATTN_WIDTH + ATTN_HEADS
MEM_LEN = 256
CROSS_HEADS = 4
CROSS_HEAD_DIM = D_MODEL // CROSS_HEADS
N_EXPERTS = 32
TOP_K = 4
D_FF = D_MODEL
SWIGLU_ALPHA = 1.702
SWIGLU_LIMIT = 7.0
MOE_BLOCK = 256
RMS_EPS = 1e-5
DT_MIN = 1e-3
DT_MAX = 1e-1
FORGET_BIAS_INIT = 2.0

kernel_name = "hybrid_s5_fox_moe_layer"


def rmsnorm(x, g):
    xf = x.astype(jnp.float32)
    y = xf * lax.rsqrt(jnp.mean(xf * xf, axis=-1, keepdims=True) + RMS_EPS)
    return (y * g.astype(jnp.float32)).astype(x.dtype)


def _complex_affine_combine(e1, e2):
    a1r, a1i, b1r, b1i = e1
    a2r, a2i, b2r, b2i = e2
    ar = a2r * a1r - a2i * a1i
    ai = a2r * a1i + a2i * a1r
    br = a2r * b1r - a2i * b1i + b2r
    bi = a2r * b1i + a2i * b1r + b2i
    return (ar, ai, br, bi)


def s5_mixer(u, lam_re, lam_im, log_step, b_re, b_im, c_re, c_im, d_skip, w_glu, b_glu):
    bsz, length, _ = u.shape
    uf = u.astype(jnp.float32).reshape(bsz, length, SSM_GROUPS, SSM_GROUP)
    lr = lam_re.astype(jnp.float32)
    li = lam_im.astype(jnp.float32)
    dt = jnp.exp(log_step.astype(jnp.float32))[:, None]
    mag = jnp.exp(lr * dt)
    lb_re = mag * jnp.cos(li * dt)
    lb_im = mag * jnp.sin(li * dt)
    den = lr * lr + li * li
    nr = lb_re - 1.0
    ni = lb_im
    coef_re = (nr * lr + ni * li) / den
    coef_im = (ni * lr - nr * li) / den
    br = b_re.astype(jnp.float32)
    bi = b_im.astype(jnp.float32)
    bb_re = coef_re[..., None] * br - coef_im[..., None] * bi
    bb_im = coef_re[..., None] * bi + coef_im[..., None] * br
    bu_re = jnp.einsum('blgh,gph->blgp', uf, bb_re)
    bu_im = jnp.einsum('blgh,gph->blgp', uf, bb_im)
    a_re = jnp.broadcast_to(lb_re, bu_re.shape)
    a_im = jnp.broadcast_to(lb_im, bu_im.shape)
    _, _, xs_re, xs_im = lax.associative_scan(
        _complex_affine_combine, (a_re, a_im, bu_re, bu_im), axis=1)
    y = (jnp.einsum('blgp,ghp->blgh', xs_re, c_re.astype(jnp.float32))
         - jnp.einsum('blgp,ghp->blgh', xs_im, c_im.astype(jnp.float32))
         + d_skip.astype(jnp.float32).reshape(SSM_GROUPS, SSM_GROUP) * uf)
    y = jax.nn.gelu(y.reshape(bsz, length, SSM_WIDTH))
    y = y * jax.nn.sigmoid(y @ w_glu.astype(jnp.float32) + b_glu.astype(jnp.float32))
    return y.astype(u.dtype)


def fox_attention(q, k, v, f_logit):
    bsz, length, _ = q.shape
    def heads(t):
        return t.reshape(bsz, length, ATTN_HEADS, ATTN_HEAD_DIM).transpose(0, 2, 1, 3)
    q, k, v = heads(q), heads(k), heads(v)
    log_f = jax.nn.log_sigmoid(f_logit.astype(jnp.float32)).transpose(0, 2, 1)
    cum = jnp.cumsum(log_f, axis=-1)
    nb = length // Q_BLOCK
    q_blocks = q.reshape(bsz, ATTN_HEADS, nb, Q_BLOCK, ATTN_HEAD_DIM).transpose(2, 0, 1, 3, 4)
    c_blocks = cum.reshape(bsz, ATTN_HEADS, nb, Q_BLOCK).transpose(2, 0, 1, 3)
    kpos = jnp.arange(length)
    scale = ATTN_HEAD_DIM ** -0.5

    def one_block(args):
        qb, cb, i = args
        s = jnp.einsum('bhqd,bhkd->bhqk', qb, k, preferred_element_type=jnp.float32) * scale
        s = s + cb[..., None] - cum[:, :, None, :]
        qpos = i * Q_BLOCK + jnp.arange(Q_BLOCK)
        s = jnp.where(kpos[None, :] <= qpos[:, None], s, -jnp.inf)
        p = jax.nn.softmax(s, axis=-1)
        return jnp.einsum('bhqk,bhkd->bhqd', p.astype(v.dtype), v)

    o = lax.map(one_block, (q_blocks, c_blocks, jnp.arange(nb)))
    return o.transpose(1, 0, 3, 2, 4).reshape(bsz, length, ATTN_WIDTH)


def cross_attention(h, mem_n, w_cq, w_ckv, w_co):
    bsz, length, _ = h.shape
    q = (h @ w_cq).reshape(bsz, length, CROSS_HEADS, CROSS_HEAD_DIM)
    k, v = jnp.split(mem_n @ w_ckv, 2, axis=-1)
    k = k.reshape(bsz, -1, CROSS_HEADS, CROSS_HEAD_DIM)
    v = v.reshape(bsz, -1, CROSS_HEADS, CROSS_HEAD_DIM)
    s = jnp.einsum('blhd,bmhd->bhlm', q, k, preferred_element_type=jnp.float32) * CROSS_HEAD_DIM ** -0.5
    p = jax.nn.softmax(s, axis=-1)
    o = jnp.einsum('bhlm,bmhd->blhd', p.astype(v.dtype), v).reshape(bsz, length, D_MODEL)
    return o @ w_co


def moe_ffn(h, w_router, b_router, w_gu, b_gu, w_dn, b_dn):
    bsz, length, dm = h.shape
    n_tok = bsz * length
    n_asg = n_tok * TOP_K
    xf = h.reshape(n_tok, dm)
    logits = (xf @ w_router + b_router).astype(jnp.float32)
    top_v, top_i = lax.top_k(logits, TOP_K)
    gates = jax.nn.softmax(top_v, axis=-1)
    flat_e = top_i.reshape(-1)
    flat_g = gates.reshape(-1)
    flat_tok = jnp.arange(n_asg, dtype=jnp.int32) // TOP_K
    order = jnp.argsort(flat_e)
    sorted_e = flat_e[order]
    counts = jnp.bincount(flat_e, length=N_EXPERTS)
    padded = ((counts + MOE_BLOCK - 1) // MOE_BLOCK) * MOE_BLOCK
    pend = jnp.cumsum(padded)
    pstart = pend - padded
    cstart = jnp.cumsum(counts) - counts
    dest = pstart[sorted_e] + (jnp.arange(n_asg) - cstart[sorted_e])
    n_rows = ((n_asg + MOE_BLOCK - 1) // MOE_BLOCK) * MOE_BLOCK + N_EXPERTS * MOE_BLOCK
    n_blocks = n_rows // MOE_BLOCK
    row_tok = jnp.full((n_rows,), n_tok, jnp.int32).at[dest].set(flat_tok[order])
    row_w = jnp.zeros((n_rows,), jnp.float32).at[dest].set(flat_g[order])
    blk_e = jnp.clip(jnp.searchsorted(pend, jnp.arange(n_blocks) * MOE_BLOCK, side='right'),
                     0, N_EXPERTS - 1)
    xpad = jnp.concatenate([xf, jnp.zeros((1, dm), xf.dtype)], axis=0)
    xrows = xpad[row_tok].reshape(n_blocks, MOE_BLOCK, dm)

    def expert_block(args):
        xb, e = args
        gu = xb @ w_gu[e] + b_gu[e]
        g, lin = jnp.split(gu, 2, axis=-1)
        g = jnp.minimum(g, SWIGLU_LIMIT)
        lin = jnp.clip(lin, -SWIGLU_LIMIT, SWIGLU_LIMIT)
        act = g * jax.nn.sigmoid(SWIGLU_ALPHA * g) * (lin + 1.0)
        return act @ w_dn[e] + b_dn[e]

    yrows = lax.map(expert_block, (xrows, blk_e)).reshape(n_rows, dm)
    y = jax.ops.segment_sum(yrows * row_w[:, None].astype(yrows.dtype), row_tok,
                            num_segments=n_tok + 1)[:n_tok]
    return y.reshape(bsz, length, dm)


def setup_inputs(seed: int = 0) -> dict:
    key = jax.random.key(seed)
    ks = jax.random.split(key, 32)
    f32 = jnp.float32
    nrm = lambda k, shape, s: jax.random.normal(k, shape, f32) * s
    gain = lambda k, shape: 1.0 + 0.02 * jax.random.normal(k, shape, f32)
    L, D, G, P, H = DEPTH, D_MODEL, SSM_GROUPS, SSM_STATE, SSM_GROUP
    n_idx = jnp.arange(P, dtype=f32)
    return {
        'x': jax.random.normal(ks[0], (BATCH, SEQ, D), f32),
        'mem': jax.random.normal(ks[1], (BATCH, MEM_LEN, D), f32),
        'g_mix': gain(ks[2], (L, D)),
        'w_in': nrm(ks[3], (L, D, IN_COLS), D ** -0.5),
        'b_f': FORGET_BIAS_INIT + 0.5 * jax.random.normal(ks[4], (L, ATTN_HEADS), f32),
        'lam_re': -0.5 + 0.01 * jax.random.normal(ks[5], (L, G, P), f32),
        'lam_im': jnp.pi * n_idx + 0.01 * jax.random.normal(ks[6], (L, G, P), f32),
        'log_step': jax.random.uniform(ks[7], (L, G), f32, math.log(DT_MIN), math.log(DT_MAX)),
        'b_re': nrm(ks[8], (L, G, P, H), (2 * H) ** -0.5),
        'b_im': nrm(ks[9], (L, G, P, H), (2 * H) ** -0.5),
        'c_re': nrm(ks[10], (L, G, H, P), (2 * P) ** -0.5),
        'c_im': nrm(ks[11], (L, G, H, P), (2 * P) ** -0.5),
        'd_skip': nrm(ks[12], (L, SSM_WIDTH), 1.0),
        'w_glu': nrm(ks[13], (L, SSM_WIDTH, SSM_WIDTH), SSM_WIDTH ** -0.5),
        'b_glu': nrm(ks[14], (L, SSM_WIDTH), 0.01),
        'g_attn_out': gain(ks[15], (L, ATTN_WIDTH)),
        'g_ssm_out': gain(ks[16], (L, SSM_WIDTH)),
        'w_out': nrm(ks[17], (L, D, D), D ** -0.5),
        'g_cross': gain(ks[18], (L, D)),
        'g_mem': gain(ks[19], (L, D)),
        'w_cq': nrm(ks[20], (L, D, D), D ** -0.5),
        'w_ckv': nrm(ks[21], (L, D, 2 * D), D ** -0.5),
        'w_co': nrm(ks[22], (L, D, D), D ** -0.5),
        'g_moe': gain(ks[23], (L, D)),
        'w_router': nrm(ks[24], (L, D, N_EXPERTS), D ** -0.5),
        'b_router': nrm(ks[25], (L, N_EXPERTS), 0.01),
        'w_gu': nrm(ks[26], (L, N_EXPERTS, D, 2 * D_FF), D ** -0.5),
        'b_gu': nrm(ks[27], (L, N_EXPERTS, 2 * D_FF), 0.01),
        'w_dn': nrm(ks[28], (L, N_EXPERTS, D_FF, D), D_FF ** -0.5),
        'b_dn': nrm(ks[29], (L, N_EXPERTS, D), 0.01),
        'g_final': gain(ks[30], (D,)),
    }


def reference(x, mem, g_mix, w_in, b_f, lam_re, lam_im, log_step, b_re, b_im, c_re, c_im,
              d_skip, w_glu, b_glu, g_attn_out, g_ssm_out, w_out, g_cross, g_mem, w_cq, w_ckv,
              w_co, g_moe, w_router, b_router, w_gu, b_gu, w_dn, b_dn, g_final):
    h = x
    s1 = SSM_WIDTH
    s2 = s1 + ATTN_WIDTH
    s3 = s2 + ATTN_WIDTH
    s4 = s3 + ATTN_WIDTH
    for layer in range(DEPTH):
        n = rmsnorm(h, g_mix[layer])
        u, q, k, v, fl = jnp.split(n @ w_in[layer], [s1, s2, s3, s4], axis=-1)
        att = fox_attention(q, k, v, fl + b_f[layer])
        ssm = s5_mixer(u, lam_re[layer], lam_im[layer], log_step[layer], b_re[layer],
                       b_im[layer], c_re[layer], c_im[layer], d_skip[layer], w_glu[layer],
                       b_glu[layer])
        mixed = jnp.concatenate([rmsnorm(att, g_attn_out[layer]),
                                 rmsnorm(ssm, g_ssm_out[layer])], axis=-1)
        h = h + mixed @ w_out[layer]
        h = h + cross_attention(rmsnorm(h, g_cross[layer]), rmsnorm(mem, g_mem[layer]),
                                w_cq[layer], w_ckv[layer], w_co[layer])
        h = h + moe_ffn(rmsnorm(h, g_moe[layer]), w_router[layer], b_router[layer],
                        w_gu[layer], b_gu[layer], w_dn[layer], b_dn[layer])
    return rmsnorm(h, g_final)
```

```cpp
#include <hip/hip_runtime.h>
#include <cstdio>
#include <cstdint>

#define GAS __attribute__((address_space(1)))
#define LAS __attribute__((address_space(3)))
typedef _Float16 f16;
typedef _Float16 f16x2 __attribute__((ext_vector_type(2)));
typedef _Float16 f16x4 __attribute__((ext_vector_type(4)));
typedef _Float16 f16x8 __attribute__((ext_vector_type(8)));
typedef float f32x2 __attribute__((ext_vector_type(2)));
typedef float f32x4 __attribute__((ext_vector_type(4)));
typedef float f32x16 __attribute__((ext_vector_type(16)));
typedef unsigned u32x2 __attribute__((ext_vector_type(2)));
typedef unsigned u32x4 __attribute__((ext_vector_type(4)));
typedef GAS unsigned gu32;
#define RLX_AGENT __ATOMIC_RELAXED, __HIP_MEMORY_SCOPE_AGENT
#define LDS_WAIT() asm volatile("s_waitcnt lgkmcnt(0)" ::: "memory")
#define VM_WAIT() asm volatile("s_waitcnt vmcnt(0)" ::: "memory")

constexpr int BATCH = 2, SEQ = 8192, DM = 2048, M = BATCH * SEQ;
constexpr int SSMW = 1024, SG = 16, NG = 64, SP = 64;
constexpr int AW = 1024, AH = 8, AD = 128;
constexpr int INC = SSMW + 3 * AW + AH;
constexpr int MEML = 256, CH = 4, CD = 512;
constexpr int NE = 32, TOPK = 4, DFF = 2048;
constexpr float EPS = 1e-5f;
constexpr int CT = 64, NCH = SEQ / CT;

__device__ __forceinline__ unsigned pk2h(float lo, float hi) { f32x2 v = {lo, hi}; f16x2 h = __builtin_convertvector(v, f16x2); return __builtin_bit_cast(unsigned, h); }
__device__ __forceinline__ u32x2 pack8q(f32x4 a, f32x4 b) { unsigned w0 = 0, w1 = 0;
    w0 = __builtin_amdgcn_cvt_pk_fp8_f32(a[0], a[1], w0, false); w0 = __builtin_amdgcn_cvt_pk_fp8_f32(a[2], a[3], w0, true);
    w1 = __builtin_amdgcn_cvt_pk_fp8_f32(b[0], b[1], w1, false); w1 = __builtin_amdgcn_cvt_pk_fp8_f32(b[2], b[3], w1, true); return (u32x2){w0, w1}; }
constexpr float XH_SCALE = 16.0f, XK_SCALE = 256.0f, XP_SCALE = 256.0f, XV_SCALE = 16.0f;
constexpr float WQ_SCALE = 32.0f, WQ_INV = 1.0f / 32.0f;
__device__ __forceinline__ f16x8 pack8h(f32x4 a, f32x4 b) { u32x4 w = {pk2h(a[0], a[1]), pk2h(a[2], a[3]), pk2h(b[0], b[1]), pk2h(b[2], b[3])}; return __builtin_bit_cast(f16x8, w); }
__device__ __forceinline__ int opaque_tid() { int t = threadIdx.x; asm volatile("" : "+v"(t)); return t; }
__device__ __forceinline__ const char* uptr(const char* p) {
    const unsigned long long v = (unsigned long long)p; const unsigned lo = __builtin_amdgcn_readfirstlane((unsigned)v), hi = __builtin_amdgcn_readfirstlane((unsigned)(v >> 32));
    return (const char*)(((unsigned long long)hi << 32) | lo); }
__device__ __forceinline__ float wave_sum(float v) {
#pragma unroll
    for (int o = 1; o < 64; o <<= 1) v += __shfl_xor(v, o);
    return v;
}

#define XB_TMO      128
#define XB_XCNT(j)  (256  + 64 * (j))
#define XB_XSUB(j)  (1280 + 64 * (j))
#define XB_XGEN(j)  (2304 + 64 * (j))
#define XB_TOP      3328
#define XB_TOPGEN   3392
#define XCD_BAR_WORDS 3456
#define XB_SPIN_CAP (1u << 18)
__device__ __forceinline__ unsigned xb_ld(unsigned* p)              { return __hip_atomic_load(p, __ATOMIC_RELAXED, __HIP_MEMORY_SCOPE_AGENT); }
__device__ __forceinline__ unsigned xb_add(unsigned* p, unsigned v) { return __hip_atomic_fetch_add(p, v, __ATOMIC_RELAXED, __HIP_MEMORY_SCOPE_AGENT); }
__device__ __forceinline__ unsigned xb_xcc_id() { return (unsigned)__builtin_amdgcn_s_getreg((3 << 11) | 20) & 0xFu; }
#define XB_SPIN(cond, bar) do { unsigned _sp = 0; while (cond) { __builtin_amdgcn_s_sleep(1); \
    if ((++_sp & 255u) == 0u) { if (xb_ld(&(bar)[XB_TMO])) break; if (_sp > XB_SPIN_CAP) { atomicAdd(&(bar)[XB_TMO], 1u); break; } } } } while (0)
struct XcdBarrier { unsigned* bar; unsigned x; volatile LAS unsigned* st; unsigned gexp; };
__device__ __forceinline__ XcdBarrier xcd_barrier_post(unsigned* bar, volatile LAS unsigned* st, unsigned gexp = 0u) {
    XcdBarrier b; b.bar = bar; b.x = xb_xcc_id(); b.st = st; b.gexp = gexp;
    if (threadIdx.x == 0) (void)xb_add(&bar[XB_XCNT(b.x)], 1u);
    return b;
}
__device__ __forceinline__ void xcd_barrier_complete(unsigned* bar, unsigned x, unsigned& nloc, unsigned& nx, unsigned gexp) {
    const unsigned G = gexp ? gexp : gridDim.x * gridDim.y * gridDim.z;
    unsigned sum, cnt, mine, sp = 0u;
    for (;;) {
        sum = 0u; cnt = 0u; mine = 0u;
#pragma unroll
        for (unsigned j = 0; j < 16; ++j) { const unsigned c = xb_ld(&bar[XB_XCNT(j)]); sum += c; cnt += (c > 0u) ? 1u : 0u; mine = (j == x) ? c : mine; }
        if (sum == G) break;
        __builtin_amdgcn_s_sleep(1);
        if ((++sp & 255u) == 0u) { if (xb_ld(&bar[XB_TMO])) break; if (sp > XB_SPIN_CAP) { atomicAdd(&bar[XB_TMO], 1u); break; } }
    }
    nloc = mine > 0u ? mine : 1u; nx = cnt > 0u ? cnt : 1u;
}
__device__ __forceinline__ void xcd_barrier(const XcdBarrier& b) {
    asm volatile("s_waitcnt vmcnt(0)" ::: "memory");
    __syncthreads();
    if (threadIdx.x == 0) {
        unsigned* bar = b.bar;
        __builtin_amdgcn_s_waitcnt(0);
        unsigned nloc = b.st[0], nx = b.st[1];
        if (nloc == 0u) { xcd_barrier_complete(bar, b.x, nloc, nx, b.gexp); b.st[0] = nloc; b.st[1] = nx; }
        const unsigned old = xb_add(&bar[XB_XSUB(b.x)], 1u);
        const unsigned gen = old / nloc;
        if (old + 1u == (gen + 1u) * nloc) {
            __builtin_amdgcn_fence(__ATOMIC_RELEASE, "agent");
            asm volatile("s_waitcnt vmcnt(0)" ::: "memory");
            const unsigned og = xb_add(&bar[XB_TOP], 1u);
            const unsigned tg = og / nx;
            if (og + 1u == (tg + 1u) * nx) xb_add(&bar[XB_TOPGEN], 1u);
            else XB_SPIN(xb_ld(&bar[XB_TOPGEN]) == tg, bar);
            __builtin_amdgcn_fence(__ATOMIC_ACQUIRE, "agent");
            xb_add(&bar[XB_XGEN(b.x)], 1u);
            asm volatile("s_waitcnt vmcnt(0)" ::: "memory");
        } else {
            XB_SPIN(xb_ld(&bar[XB_XGEN(b.x)]) == gen, bar);
            __builtin_amdgcn_fence(__ATOMIC_ACQUIRE, "agent");
            asm volatile("s_waitcnt vmcnt(0)" ::: "memory");
        }
    }
    __syncthreads();
}

namespace pg8 {
constexpr int BM = 256, BK = 64, HALF = 128, HTB = HALF * BK * 2, STAGE_BYTES = 8 * HTB, NXCD = 8, WGM = 8;
__host__ __device__ __forceinline__ int lds_byte(int r, int c) { const int st = (r >> 4) * 2 + (c >> 5), rr = r & 15, cc = c & 31, ob = rr * 64 + cc * 2; return st * 1024 + (ob ^ (((ob >> 9) & 1) << 5)); }
__host__ __device__ __forceinline__ void stage_rc(int b, int& R, int& C) { const int st = b / 1024, sb = b % 1024, swz = sb ^ (((sb >> 9) & 1) << 5); R = (st >> 1) * 16 + swz / 64; C = (st & 1) * 32 + (swz % 64) / 2; }
__host__ __device__ __forceinline__ int perm32(int rho) { const int n = rho >> 4, i = rho & 15; return 8 * (i >> 2) + 4 * n + (i & 3); }

struct Unit { int pm, pn, aux; };

struct DenseOrder {
    static constexpr bool GATHER = false;
    const f16* A; const f16* Bt; int K; int nM, nN, nwg, G, c; size_t bstride;
    __device__ void init(const f16* A_, const f16* Bt_, int M_, int N_, int K_, int G_, int c_, size_t bstride_ = 0) { A = A_; Bt = Bt_; K = K_; nM = M_ / BM; nN = N_ / BM; nwg = nM * nN; G = G_; c = c_; bstride = bstride_; }
    __device__ bool next(int i, Unit& u) const {
        const long L = (long)i * G + c; if (L >= nwg) return false;
        int wgid = (int)L; { const int q = nwg / NXCD, r = nwg % NXCD, xcd = wgid % NXCD, off = wgid / NXCD; wgid = (xcd < r ? xcd * (q + 1) : r * (q + 1) + (xcd - r) * q) + off; }
        const int nig = WGM * nN, gid = wgid / nig, fm = gid * WGM, gsz = (nM - fm) < WGM ? (nM - fm) : WGM;
        u.pm = fm + ((wgid % nig) % gsz); u.pn = (wgid % nig) / gsz; u.aux = 0; return true;
    }
    __device__ __forceinline__ int pitch_a() const { return K * 2; }
    __device__ __forceinline__ int pitch_b() const { return K * 2; }
    __device__ __forceinline__ const char* a_ptr(const Unit& u) const { return (const char*)A + (size_t)u.pm * BM * K * 2; }
    __device__ __forceinline__ const char* b_ptr(const Unit& u) const { return (const char*)Bt + (size_t)(u.pm >> 5) * bstride + (size_t)u.pn * BM * K * 2; }
    __device__ __forceinline__ unsigned a_row(const Unit&, int r) const { return (unsigned)r; }
};
template <int TYPE>
struct CrossPre {
    static constexpr bool GATHER = false;
    const f16* KVC; const f16* W; int c;
    __device__ bool next(int i, Unit& u) const { if (i > 0 || c < 0 || c >= 64) return false; u.pm = c >> 3; u.pn = c & 7; u.aux = TYPE; return true; }
    __device__ __forceinline__ int pitch_a() const { return TYPE == 0 ? 2 * DM * 2 : DM * 2; }
    __device__ __forceinline__ int pitch_b() const { return TYPE == 0 ? DM * 2 : 2 * DM * 2; }
    __device__ __forceinline__ const char* kv(const Unit& u) const { return (const char*)(KVC + (size_t)((u.pm >> 2) * MEML) * (2 * DM) + (TYPE == 0 ? 0 : DM) + (u.pm & 3) * CD); }
    __device__ __forceinline__ const char* w(const Unit& u) const { return (const char*)(W + (size_t)(u.pn * 256) * DM + (u.pm & 3) * CD); }
    __device__ __forceinline__ const char* a_ptr(const Unit& u) const { return TYPE == 0 ? kv(u) : w(u); }
    __device__ __forceinline__ const char* b_ptr(const Unit& u) const { return TYPE == 0 ? w(u) : kv(u); }
    __device__ __forceinline__ unsigned a_row(const Unit&, int r) const { return (unsigned)r; }
};
typedef int i32x4 __attribute__((ext_vector_type(4)));
typedef int i32x8 __attribute__((ext_vector_type(8)));
template <class Epi, class Sched, bool MIDSCALE = false, bool FP8 = false, bool SP2 = true>
__device__ __forceinline__ void gemm_phase(LAS unsigned char* lds, const int KB, const Sched& S, const Epi& E, LAS float* msl = nullptr) {
    const int tid = opaque_tid(), wid = __builtin_amdgcn_readfirstlane(tid >> 6), lane = tid & 63, wr = wid >> 2, wc = wid & 3, fr = lane & 15, fq = lane >> 4;
    const int nt = KB / 128, pitchA = S.pitch_a(), pitchB = S.pitch_b();
    int sR[2], sC[2]; unsigned voffB[2];
#pragma unroll
    for (int i = 0; i < 2; ++i) { int R, C; stage_rc(tid * 16 + i * 8192, R, C); const int Rb = Epi::PERM ? ((R & ~31) + perm32(R & 31)) : R; sR[i] = R; sC[i] = C; voffB[i] = (unsigned)(Rb * pitchB + C * 2); }
    const size_t kstep = (size_t)(BK * 2);
    const size_t hstepB = (size_t)HALF * pitchB;
    const unsigned ldsw = (unsigned)wid * 1024u;
    const int aoff = lds_byte(wr * 64 + fr, fq * 8), boff = lds_byte(wc * 32 + fr, fq * 8);
#define PG8_SA(b, h) (((b) * 2 + (h)) * HTB)
#define PG8_SB(b, h) ((4 + (b) * 2 + (h)) * HTB)
#define PG8_STAGE2(bufoff, gbase, o0, o1) do { \
        __builtin_amdgcn_global_load_lds((const unsigned*)((const char*)(gbase) + (o0)), (LAS unsigned*)(lds + (bufoff) + ldsw), 16, 0, 0); \
        __builtin_amdgcn_global_load_lds((const unsigned*)((const char*)(gbase) + (o1)), (LAS unsigned*)(lds + (bufoff) + ldsw + 8192), 16, 0, 0); } while (0)
#define PG8_STAGE(bufoff, gbase, voff) PG8_STAGE2(bufoff, gbase, (voff)[0], (voff)[1])
#define PG8_SEL(h, i) ((Sched::GATHER && last) ? vN[h][i] : vA[h][i])
#define PG8_LD8(p) __builtin_shufflevector(*(const LAS i32x4*)(p), *(const LAS i32x4*)((p) + 1024), 0, 1, 2, 3, 4, 5, 6, 7)
#define PG8_LDA(dst, b, h) do { _Pragma("unroll") for (int m = 0; m < 4; ++m) dst[m] = PG8_LD8(lds + PG8_SA(b, h) + aoff + m * 2048); } while (0)
#define PG8_LDB(dst, b, h) do { _Pragma("unroll") for (int n = 0; n < 2; ++n) dst[n] = PG8_LD8(lds + PG8_SB(b, h) + boff + n * 2048); } while (0)
#define PG8_H0(x) __builtin_bit_cast(f16x8, __builtin_shufflevector(x, x, 0, 1, 2, 3))
#define PG8_H1(x) __builtin_bit_cast(f16x8, __builtin_shufflevector(x, x, 4, 5, 6, 7))
#define PG8_MMA(ai, bj, At, Bt) do { __builtin_amdgcn_s_setprio(1); \
        if constexpr (FP8) { _Pragma("unroll") for (int m = 0; m < 4; ++m) _Pragma("unroll") for (int n = 0; n < 2; ++n) \
            asm volatile("v_mfma_f32_16x16x128_f8f6f4 %0, %1, %2, %0" : "+v"(acc[ai][bj][m][n]) : "v"(Bt[n]), "v"(At[m])); } \
        else { _Pragma("unroll") for (int m = 0; m < 4; ++m) _Pragma("unroll") for (int n = 0; n < 2; ++n) { \
            acc[ai][bj][m][n] = __builtin_amdgcn_mfma_f32_16x16x32_f16(PG8_H0(Bt[n]), PG8_H0(At[m]), acc[ai][bj][m][n], 0, 0, 0); \
            acc[ai][bj][m][n] = __builtin_amdgcn_mfma_f32_16x16x32_f16(PG8_H1(Bt[n]), PG8_H1(At[m]), acc[ai][bj][m][n], 0, 0, 0); } } \
        __builtin_amdgcn_s_setprio(0); } while (0)
#define PG8_WAIT_V(n) asm volatile("s_waitcnt vmcnt(" #n ")" ::: "memory")
#define PG8_WAIT_L(n) asm volatile("s_waitcnt lgkmcnt(" #n ")" ::: "memory")
#define PG8_BAR __builtin_amdgcn_s_barrier()
#define PG8_SCHED __builtin_amdgcn_sched_barrier(0)
#define PG8_VOFFA(dst, u) do { _Pragma("unroll") for (int _h = 0; _h < 2; ++_h) _Pragma("unroll") for (int _i = 0; _i < 2; ++_i) dst[_h][_i] = S.a_row(u, _h * HALF + sR[_i]) * (unsigned)pitchA + (unsigned)sC[_i] * 2u; } while (0)
    Unit cur, nxt; int ui = 0;
    if (!S.next(0, cur)) return;
    f32x4 acc[2][2][4][2];
#pragma unroll
    for (int a = 0; a < 2; ++a)
#pragma unroll
        for (int b = 0; b < 2; ++b)
#pragma unroll
            for (int m = 0; m < 4; ++m)
#pragma unroll
                for (int n = 0; n < 2; ++n) acc[a][b][m][n] = (f32x4){0.f, 0.f, 0.f, 0.f};
    const int one_scale = 0x7F7F7F7F;
    (void)one_scale;
    i32x8 At[4], B0[2], B1[2];
    unsigned vA[2][2], vN[2][2];
    const char* cA = S.a_ptr(cur); const char* cB = S.b_ptr(cur);
    PG8_VOFFA(vA, cur);
    if constexpr (SP2) {
        PG8_STAGE(PG8_SB(0, 0), cB, voffB); PG8_STAGE(PG8_SB(0, 1), cB + hstepB, voffB); PG8_STAGE(PG8_SA(0, 0), cA, vA[0]); PG8_STAGE(PG8_SA(0, 1), cA, vA[1]);
        if (wr == 1) PG8_BAR;
        PG8_WAIT_V(2); PG8_BAR;
        PG8_STAGE(PG8_SB(1, 0), cB + kstep, voffB); PG8_STAGE(PG8_SA(1, 0), cA + kstep, vA[0]); PG8_STAGE(PG8_SB(1, 1), cB + hstepB + kstep, voffB);
        PG8_WAIT_V(6); PG8_BAR;
    } else {
    PG8_STAGE(PG8_SB(0, 0), cB, voffB); PG8_STAGE(PG8_SA(0, 0), cA, vA[0]); PG8_STAGE(PG8_SB(0, 1), cB + hstepB, voffB); PG8_STAGE(PG8_SA(0, 1), cA, vA[1]);
    if (wr == 1) PG8_BAR;
    PG8_WAIT_V(4); PG8_BAR;
    PG8_STAGE(PG8_SB(1, 0), cB + kstep, voffB); PG8_STAGE(PG8_SA(1, 0), cA + kstep, vA[0]); PG8_STAGE(PG8_SB(1, 1), cB + hstepB + kstep, voffB);
    PG8_WAIT_V(6); PG8_BAR;
    }
    for (;;) {
        const bool has_next = S.next(ui + 1, nxt);
        const char* nA = has_next ? S.a_ptr(nxt) : cA + 2 * kstep; const char* nB = has_next ? S.b_ptr(nxt) : cB + 2 * kstep;
        if constexpr (MIDSCALE) E.midscale_store(msl, cur, tid);
#ifndef KLOOP_REP
#define KLOOP_REP 1
#endif
#ifndef KLOOP_FP8
#define KLOOP_FP8 true
#endif
        for (int kp_ = 0; kp_ < ((FP8 == KLOOP_FP8) ? KLOOP_REP : 1); ++kp_) {
        const bool lastpass = (kp_ == ((FP8 == KLOOP_FP8) ? KLOOP_REP : 1) - 1);
        if (kp_ > 0) {
#pragma unroll
            for (int a = 0; a < 2; ++a)
#pragma unroll
                for (int b = 0; b < 2; ++b)
#pragma unroll
                    for (int m = 0; m < 4; ++m)
#pragma unroll
                        for (int n = 0; n < 2; ++n) acc[a][b][m][n] = (f32x4){0.f, 0.f, 0.f, 0.f}; }
        for (int t = 0; t < nt; t += 2) {
            const bool last = (t == nt - 2);
            const char* a1 = uptr(cA + (size_t)(t + 1) * kstep);
            const char* a2 = uptr(last ? (lastpass ? nA : cA) : cA + (size_t)(t + 2) * kstep); const char* b2 = uptr(last ? (lastpass ? nB : cB) : cB + (size_t)(t + 2) * kstep);
            const char* a3 = a2 + kstep; const char* b3 = b2 + kstep;
            if constexpr (Sched::GATHER) {
                if (t == nt - 4) { if (has_next && lastpass) { PG8_VOFFA(vN, nxt); } else {
#pragma unroll
                    for (int _h = 0; _h < 2; ++_h)
#pragma unroll
                        for (int _i = 0; _i < 2; ++_i) vN[_h][_i] = vA[_h][_i]; } } }
            if constexpr (MIDSCALE) { if (t == nt / 2) {
#pragma unroll
                for (int a = 0; a < 2; ++a)
#pragma unroll
                    for (int m = 0; m < 4; ++m) { const float sc_ = msl[a * HALF + wr * 64 + m * 16 + fr];
#pragma unroll
                        for (int b = 0; b < 2; ++b)
#pragma unroll
                            for (int n = 0; n < 2; ++n) acc[a][b][m][n] = acc[a][b][m][n] * sc_; }
                PG8_SCHED; } }
            if constexpr (SP2) {
            PG8_LDB(B0, 0, 0); PG8_LDB(B1, 0, 1); PG8_SCHED; PG8_LDA(At, 0, 0); PG8_STAGE(PG8_SA(1, 1), a1, vA[1]);
            PG8_WAIT_V(8); PG8_WAIT_L(0); PG8_BAR; PG8_MMA(0, 0, At, B0); PG8_MMA(0, 1, At, B1); PG8_BAR; PG8_SCHED;
            PG8_LDA(At, 0, 1); PG8_STAGE(PG8_SB(0, 0), b2, voffB); PG8_STAGE(PG8_SB(0, 1), b2 + hstepB, voffB); PG8_STAGE2(PG8_SA(0, 0), a2, PG8_SEL(0, 0), PG8_SEL(0, 1));
            PG8_WAIT_V(8); PG8_WAIT_L(0); PG8_BAR; PG8_MMA(1, 0, At, B0); PG8_MMA(1, 1, At, B1); PG8_BAR; PG8_SCHED;
            PG8_LDB(B0, 1, 0); PG8_LDB(B1, 1, 1); PG8_SCHED; PG8_LDA(At, 1, 0); PG8_STAGE2(PG8_SA(0, 1), a2, PG8_SEL(1, 0), PG8_SEL(1, 1));
            PG8_WAIT_V(8); PG8_WAIT_L(0); PG8_BAR; PG8_MMA(0, 0, At, B0); PG8_MMA(0, 1, At, B1); PG8_BAR; PG8_SCHED;
            PG8_LDA(At, 1, 1); PG8_STAGE(PG8_SB(1, 0), b3, voffB); PG8_STAGE(PG8_SB(1, 1), b3 + hstepB, voffB); PG8_STAGE2(PG8_SA(1, 0), a3, PG8_SEL(0, 0), PG8_SEL(0, 1));
            PG8_WAIT_V(8); PG8_WAIT_L(0); PG8_BAR; PG8_MMA(1, 0, At, B0); PG8_MMA(1, 1, At, B1); PG8_BAR; PG8_SCHED;
            } else {
            PG8_LDB(B0, 0, 0); PG8_SCHED; PG8_LDA(At, 0, 0); PG8_STAGE(PG8_SA(1, 1), a1, vA[1]);
            PG8_WAIT_L(8); PG8_BAR; PG8_WAIT_L(0); PG8_MMA(0, 0, At, B0); PG8_BAR; PG8_SCHED;
            PG8_LDB(B1, 0, 1); PG8_STAGE(PG8_SB(0, 0), b2, voffB);
            PG8_BAR; PG8_WAIT_L(0); PG8_MMA(0, 1, At, B1); PG8_BAR;
            PG8_LDA(At, 0, 1); PG8_STAGE2(PG8_SA(0, 0), a2, PG8_SEL(0, 0), PG8_SEL(0, 1));
            PG8_BAR; PG8_WAIT_L(0); PG8_MMA(1, 0, At, B0); PG8_BAR; PG8_SCHED;
            PG8_STAGE(PG8_SB(0, 1), b2 + hstepB, voffB);
            PG8_WAIT_V(6); PG8_BAR; PG8_MMA(1, 1, At, B1); PG8_BAR;
            PG8_LDB(B0, 1, 0); PG8_SCHED; PG8_LDA(At, 1, 0); PG8_STAGE2(PG8_SA(0, 1), a2, PG8_SEL(1, 0), PG8_SEL(1, 1));
            PG8_WAIT_L(8); PG8_BAR; PG8_WAIT_L(0); PG8_MMA(0, 0, At, B0); PG8_BAR; PG8_SCHED;
            PG8_LDB(B1, 1, 1); PG8_STAGE(PG8_SB(1, 0), b3, voffB);
            PG8_BAR; PG8_WAIT_L(0); PG8_MMA(0, 1, At, B1); PG8_BAR;
            PG8_LDA(At, 1, 1); PG8_STAGE2(PG8_SA(1, 0), a3, PG8_SEL(0, 0), PG8_SEL(0, 1));
            PG8_BAR; PG8_WAIT_L(0); PG8_MMA(1, 0, At, B0); PG8_BAR; PG8_SCHED;
            PG8_STAGE(PG8_SB(1, 1), b3 + hstepB, voffB);
            PG8_WAIT_V(6); PG8_BAR; PG8_MMA(1, 1, At, B1); PG8_BAR;
                    }
        }
        }
        if (wr == 0) PG8_BAR;
        if constexpr (FP8) asm volatile("s_nop 15\n\ts_nop 15" ::: "memory");
#ifndef EPI_REP
#define EPI_REP 1
#endif
        for (int er_ = 0; er_ < (FP8 ? EPI_REP : 1); ++er_)
        E(acc, cur, wr, wc, fr, fq);
        if (!has_next) break;
#pragma unroll
        for (int a = 0; a < 2; ++a)
#pragma unroll
            for (int b = 0; b < 2; ++b)
#pragma unroll
                for (int m = 0; m < 4; ++m)
#pragma unroll
                    for (int n = 0; n < 2; ++n) acc[a][b][m][n] = (f32x4){0.f, 0.f, 0.f, 0.f};
        cur = nxt; cA = nA; cB = nB; ++ui;
        if (wr == 1) PG8_BAR;
        if constexpr (Sched::GATHER) {
#pragma unroll
            for (int _h = 0; _h < 2; ++_h)
#pragma unroll
                for (int _i = 0; _i < 2; ++_i) vA[_h][_i] = vN[_h][_i]; }
    }
    PG8_WAIT_V(0);
    PG8_BAR;
#undef PG8_SA
#undef PG8_SB
#undef PG8_STAGE
#undef PG8_STAGE2
#undef PG8_SEL
#undef PG8_LDA
#undef PG8_LDB
#undef PG8_MMA
#undef PG8_H0
#undef PG8_H1
#undef PG8_LD8
#undef PG8_WAIT_V
#undef PG8_WAIT_L
#undef PG8_BAR
#undef PG8_SCHED
#undef PG8_VOFFA
}
}

namespace epi {
using pg8::Unit;
typedef f32x4 Acc[2][2][4][2];
__device__ __forceinline__ float rstd_of(float ss, float inv_n) { return __builtin_amdgcn_rsqf(ss * inv_n + EPS); }
__device__ __forceinline__ float quad_sum(float s) { s += __shfl_xor(s, 16); s += __shfl_xor(s, 32); return s; }
template <int NP> __device__ __forceinline__ float ss_full(const float* p) {
    float s = 0.f;
#pragma unroll
    for (int i = 0; i < NP / 4; ++i) { const f32x4 v = *(const f32x4*)(p + 4 * i); s += (v[0] + v[1]) + (v[2] + v[3]); }
    return s;
}
template <int NP> __device__ __forceinline__ float ss_quad(const float* p, int fq) {
    return quad_sum(ss_full<NP / 4>(p + fq * (NP / 4)));
}

struct InProj {
    static constexpr bool PERM = true;
    f16* U; f16* QKV; size_t stride; int* kmax;
    __device__ __forceinline__ void operator()(const Acc& acc, const Unit& u, int wr, int wc, int fr, int fq) const {
        const int row0 = u.pm * 256 + wr * 64 + fr, colt = u.pn * 256, seg = colt >> 10, cl = colt & 1023;
        f16* base = QKV + (size_t)(seg > 0 ? seg - 1 : 0) * stride;
        float km[2] = {0.f, 0.f};
#pragma unroll
        for (int ai = 0; ai < 2; ++ai)
#pragma unroll
            for (int m = 0; m < 4; ++m) { const int row = row0 + ai * 128 + m * 16, b = row >> 13, t = row & (SEQ - 1);
#pragma unroll
                for (int bj = 0; bj < 2; ++bj) { const int col = cl + bj * 128 + wc * 32 + 8 * fq;
                    const f32x4 a0 = acc[ai][bj][m][0], a1 = acc[ai][bj][m][1];
                    const f16x8 w = pack8h(a0, a1);
                    f16* dst = (seg == 0) ? U + (((size_t)(b * NG + (col >> 4)) * SEQ + t) * SG + (col & 15)) : base + (size_t)row * 1024 + col;
                    *(f16x8*)dst = w;
                    if (seg == 2) { float sq = (a0[0] * a0[0] + a0[1] * a0[1]) + (a0[2] * a0[2] + a0[3] * a0[3]) + (a1[0] * a1[0] + a1[1] * a1[1]) + (a1[2] * a1[2] + a1[3] * a1[3]);
                        sq = quad_sum(sq); km[bj] = fmaxf(km[bj], sq); } } }
        if (seg == 2) {
#pragma unroll
            for (int bj = 0; bj < 2; ++bj) { float v = km[bj];
                v = fmaxf(v, __shfl_xor(v, 1)); v = fmaxf(v, __shfl_xor(v, 2)); v = fmaxf(v, __shfl_xor(v, 4)); v = fmaxf(v, __shfl_xor(v, 8));
                if (fr == 0 && fq == 0) { const int b = (u.pm * 256) >> 13, head = (cl >> 7) + bj; atomicMax(kmax + (b * AH + head) * 4 + wc, __float_as_int(v)); } }
        }
    }
};
struct PlainF16 {
    static constexpr bool PERM = true;
    f16* O; int ldc;
    __device__ __forceinline__ void operator()(const Acc& acc, const Unit& u, int wr, int wc, int fr, int fq) const {
        const int row0 = u.pm * 256 + wr * 64 + fr, col0 = u.pn * 256 + wc * 32 + 8 * fq;
#pragma unroll
        for (int ai = 0; ai < 2; ++ai)
#pragma unroll
            for (int m = 0; m < 4; ++m)
#pragma unroll
                for (int bj = 0; bj < 2; ++bj)
                    *(f16x8*)(O + (size_t)(row0 + ai * 128 + m * 16) * ldc + col0 + bj * 128) = pack8h(acc[ai][bj][m][0], acc[ai][bj][m][1]);
    }
};
struct Glu {
    static constexpr bool PERM = true;
    const f16* G; const float* bglu; f16* MIX; float* ss;
    __device__ __forceinline__ void operator()(const Acc& acc, const Unit& u, int wr, int wc, int fr, int fq) const {
        const int row0 = u.pm * 256 + wr * 64 + fr, col0 = u.pn * 256 + wc * 32 + 8 * fq;
        f32x4 bv[2][2];
#pragma unroll
        for (int bj = 0; bj < 2; ++bj)
#pragma unroll
            for (int n = 0; n < 2; ++n) bv[bj][n] = *(const f32x4*)(bglu + col0 + bj * 128 + 4 * n);
        f16x8 gy[2][2];
#pragma unroll
        for (int bj = 0; bj < 2; ++bj) gy[0][bj] = *(const f16x8*)(G + (size_t)row0 * 1024 + col0 + bj * 128);
#pragma unroll
        for (int s = 0; s < 8; ++s) { const int ai = s >> 2, m = s & 3, row = row0 + ai * 128 + m * 16; float sq = 0.f;
            if (s < 7) { const int rown = row0 + ((s + 1) >> 2) * 128 + ((s + 1) & 3) * 16;
#pragma unroll
                for (int bj = 0; bj < 2; ++bj) gy[(s + 1) & 1][bj] = *(const f16x8*)(G + (size_t)rown * 1024 + col0 + bj * 128); }
#pragma unroll
            for (int bj = 0; bj < 2; ++bj) { f32x4 o[2];
#pragma unroll
                for (int n = 0; n < 2; ++n)
#pragma unroll
                    for (int i = 0; i < 4; ++i) { const float z = acc[ai][bj][m][n][i] + bv[bj][n][i]; const float v = (float)gy[s & 1][bj][4 * n + i] * __builtin_amdgcn_rcpf(1.0f + __expf(-z)); o[n][i] = v; sq += v * v; }
                *(f16x8*)(MIX + (size_t)row * 2048 + 1024 + col0 + bj * 128) = pack8h(o[0], o[1]); }
            sq = quad_sum(sq);
            if (fq == 0) ss[(size_t)row * 16 + u.pn * 4 + wc] = sq; }
    }
};
struct OutProj {
    static constexpr bool PERM = true;
    const float* X; f16* HA; const float* ss_att; const float* ss_ssm; float* ss_h; unsigned char* H8;
    __device__ __forceinline__ void midscale_store(LAS float* msl, const Unit& u, int tid) const {
        if (tid < 256) { const int row = u.pm * 256 + tid; msl[tid] = rstd_of(ss_full<8>(ss_att + (size_t)row * 8), 1.0f / 1024.f) / rstd_of(ss_full<16>(ss_ssm + (size_t)row * 16), 1.0f / 1024.f); }
    }
    __device__ __forceinline__ void operator()(const Acc& acc, const Unit& u, int wr, int wc, int fr, int fq) const {
        const int row0 = u.pm * 256 + wr * 64 + fr, col0 = u.pn * 256 + wc * 32 + 8 * fq;
        float rsv[8];
#pragma unroll
        for (int s = 0; s < 8; ++s) rsv[s] = ss_quad<16>(ss_ssm + (size_t)(row0 + (s >> 2) * 128 + (s & 3) * 16) * 16, fq);
        f32x4 xv[2][4];
#pragma unroll
        for (int q = 0; q < 4; ++q) xv[0][q] = *(const f32x4*)(X + (size_t)row0 * DM + col0 + (q >> 1) * 128 + (q & 1) * 4);
#pragma unroll
        for (int s = 0; s < 8; ++s) { const int ai = s >> 2, m = s & 3, row = row0 + ai * 128 + m * 16; const float rs = rstd_of(rsv[s], 1.0f / 1024.f); float sq = 0.f;
            if (s < 7) { const int rown = row0 + ((s + 1) >> 2) * 128 + ((s + 1) & 3) * 16;
#pragma unroll
                for (int q = 0; q < 4; ++q) xv[(s + 1) & 1][q] = *(const f32x4*)(X + (size_t)rown * DM + col0 + (q >> 1) * 128 + (q & 1) * 4); }
#pragma unroll
            for (int bj = 0; bj < 2; ++bj) { f32x4 h[2];
#pragma unroll
                for (int n = 0; n < 2; ++n) { h[n] = xv[s & 1][bj * 2 + n] + acc[ai][bj][m][n] * rs; sq += (h[n][0] * h[n][0] + h[n][1] * h[n][1]) + (h[n][2] * h[n][2] + h[n][3] * h[n][3]); }
                *(f16x8*)(HA + (size_t)row * DM + col0 + bj * 128) = pack8h(h[0], h[1]);
                *(u32x2*)(H8 + (size_t)row * DM + col0 + bj * 128) = pack8q(h[0] * XH_SCALE, h[1] * XH_SCALE); }
            sq = quad_sum(sq);
            if (fq == 0) ss_h[(size_t)row * 32 + u.pn * 4 + wc] = sq; }
    }
};
struct CrossPreOut {
    static constexpr bool PERM = true;
    unsigned char* WKT; unsigned char* VWT;
    __device__ __forceinline__ void operator()(const Acc& acc, const Unit& u, int wr, int wc, int fr, int fq) const {
        const int b = u.pm >> 2, hc = u.pm & 3, r0 = wr * 64 + fr, c0 = wc * 32 + 8 * fq;
        unsigned char* O; int ldc; float sc;
        if (u.aux == 0) { O = WKT + ((size_t)(b * 1024 + hc * 256)) * DM + u.pn * 256; ldc = DM; sc = XK_SCALE; }
        else { O = VWT + ((size_t)(b * DM + u.pn * 256)) * 1024 + hc * 256; ldc = 1024; sc = XV_SCALE; }
#pragma unroll
        for (int ai = 0; ai < 2; ++ai)
#pragma unroll
            for (int m = 0; m < 4; ++m)
#pragma unroll
                for (int bj = 0; bj < 2; ++bj)
                    *(u32x2*)(O + (size_t)(r0 + ai * 128 + m * 16) * ldc + c0 + bj * 128) = pack8q(acc[ai][bj][m][0] * sc, acc[ai][bj][m][1] * sc);
    }
};
struct CrossSoftmax {
    static constexpr bool PERM = true;
    unsigned char* P; const float* ss_h; LAS float* xch;
    __device__ __forceinline__ void operator()(const Acc& acc, const Unit& u, int wr, int wc, int fr, int fq) const {
        const int rt0 = wr * 64 + fr, row0 = u.pm * 256 + rt0, col0 = u.pn * 256 + wc * 32 + 8 * fq;
        LAS float* xm = xch; LAS float* xs = xch + 4 * 256;
        float rs[8];
#pragma unroll
        for (int s = 0; s < 8; ++s) rs[s] = rstd_of(ss_quad<32>(ss_h + (size_t)(row0 + (s >> 2) * 128 + (s & 3) * 16) * 32, fq), 1.0f / 2048.f) * (1.0f / (XH_SCALE * XK_SCALE));
#pragma unroll
        for (int s = 0; s < 8; ++s) { const int ai = s >> 2, m = s & 3; float mx = -__builtin_inff();
#pragma unroll
            for (int bj = 0; bj < 2; ++bj)
#pragma unroll
                for (int n = 0; n < 2; ++n)
#pragma unroll
                    for (int i = 0; i < 4; ++i) mx = fmaxf(mx, acc[ai][bj][m][n][i]);
            mx = fmaxf(mx, __shfl_xor(mx, 16)); mx = fmaxf(mx, __shfl_xor(mx, 32));
            if (fq == 0) xm[wc * 256 + ai * 128 + rt0 + m * 16] = mx * rs[s]; }
        asm volatile("s_waitcnt lgkmcnt(0)" ::: "memory"); __builtin_amdgcn_s_barrier(); asm volatile("" ::: "memory");
        float mrow[8];
#pragma unroll
        for (int s = 0; s < 8; ++s) { const int r = (s >> 2) * 128 + rt0 + (s & 3) * 16; mrow[s] = fmaxf(fmaxf(xm[r], xm[256 + r]), fmaxf(xm[512 + r], xm[768 + r])) * 1.4426950408889634f; }
#pragma unroll
        for (int s = 0; s < 8; ++s) { const int ai = s >> 2, m = s & 3; const float sc = rs[s] * 1.4426950408889634f; float sum = 0.f;
#pragma unroll
            for (int bj = 0; bj < 2; ++bj)
#pragma unroll
                for (int n = 0; n < 2; ++n)
#pragma unroll
                    for (int i = 0; i < 4; ++i) sum += __builtin_amdgcn_exp2f(fmaf(acc[ai][bj][m][n][i], sc, -mrow[s]));
            sum = quad_sum(sum);
            if (fq == 0) xs[wc * 256 + ai * 128 + rt0 + m * 16] = sum; }
        asm volatile("s_waitcnt lgkmcnt(0)" ::: "memory"); __builtin_amdgcn_s_barrier(); asm volatile("" ::: "memory");
#pragma unroll
        for (int s = 0; s < 8; ++s) { const int ai = s >> 2, m = s & 3, r = ai * 128 + rt0 + m * 16; const float sc = rs[s] * 1.4426950408889634f;
            const float inv = XP_SCALE * __builtin_amdgcn_rcpf((xs[r] + xs[256 + r]) + (xs[512 + r] + xs[768 + r]));
#pragma unroll
            for (int bj = 0; bj < 2; ++bj) { f32x4 o[2];
#pragma unroll
                for (int n = 0; n < 2; ++n)
#pragma unroll
                    for (int i = 0; i < 4; ++i) o[n][i] = __builtin_amdgcn_exp2f(fmaf(acc[ai][bj][m][n][i], sc, -mrow[s])) * inv;
                *(u32x2*)(P + (size_t)(row0 + ai * 128 + m * 16) * 1024 + col0 + bj * 128) = pack8q(o[0], o[1]); } }
    }
};
struct CrossO {
    static constexpr bool PERM = true;
    f16* H; float* ss_h2;
    __device__ __forceinline__ void operator()(const Acc& acc, const Unit& u, int wr, int wc, int fr, int fq) const {
        const int row0 = u.pm * 256 + wr * 64 + fr, col0 = u.pn * 256 + wc * 32 + 8 * fq;
        f16x8 xv[2][2];
#pragma unroll
        for (int bj = 0; bj < 2; ++bj) xv[0][bj] = *(const f16x8*)(H + (size_t)row0 * DM + col0 + bj * 128);
#pragma unroll
        for (int s = 0; s < 8; ++s) { const int ai = s >> 2, m = s & 3, row = row0 + ai * 128 + m * 16; float sq = 0.f;
            if (s < 7) { const int rown = row0 + ((s + 1) >> 2) * 128 + ((s + 1) & 3) * 16;
#pragma unroll
                for (int bj = 0; bj < 2; ++bj) xv[(s + 1) & 1][bj] = *(const f16x8*)(H + (size_t)rown * DM + col0 + bj * 128); }
#pragma unroll
            for (int bj = 0; bj < 2; ++bj) { f32x4 h[2];
#pragma unroll
                for (int n = 0; n < 2; ++n)
#pragma unroll
                    for (int i = 0; i < 4; ++i) { h[n][i] = (float)xv[s & 1][bj][4 * n + i] + acc[ai][bj][m][n][i] * (1.0f / (XP_SCALE * XV_SCALE)); sq += h[n][i] * h[n][i]; }
                *(f16x8*)(H + (size_t)row * DM + col0 + bj * 128) = pack8h(h[0], h[1]); }
            sq = quad_sum(sq);
            if (fq == 0) ss_h2[(size_t)row * 32 + u.pn * 4 + wc] = sq; }
    }
};
struct ExpertGU {
    static constexpr bool PERM = true;
    unsigned char* ACT; const float* bgu;
    __device__ __forceinline__ void operator()(const Acc& acc, const Unit& u, int wr, int wc, int fr, int fq) const {
        const int row0 = u.pm * 256 + wr * 64 + fr, f0 = u.pn * 128 + wc * 32 + 8 * fq;
        const float* bg = bgu + (size_t)u.aux * (2 * DFF) + f0;
        f32x4 bgv[2], blv[2];
#pragma unroll
        for (int n = 0; n < 2; ++n) { bgv[n] = *(const f32x4*)(bg + 4 * n); blv[n] = *(const f32x4*)(bg + DFF + 4 * n); }
        const f32x2 winv = {WQ_INV, WQ_INV}, one2 = {1.0f, 1.0f}, kexp = {-1.702f * 1.4426950408889634f, -1.702f * 1.4426950408889634f};
#pragma unroll
        for (int ai = 0; ai < 2; ++ai)
#pragma unroll
            for (int m = 0; m < 4; ++m) { const int row = row0 + ai * 128 + m * 16; f32x4 o[2];
#pragma unroll
                for (int n = 0; n < 2; ++n)
#pragma unroll
                    for (int p = 0; p < 2; ++p) {
                        const f32x2 ag = {acc[ai][0][m][n][2 * p], acc[ai][0][m][n][2 * p + 1]}, al = {acc[ai][1][m][n][2 * p], acc[ai][1][m][n][2 * p + 1]};
                        const f32x2 bg2 = {bgv[n][2 * p], bgv[n][2 * p + 1]}, bl2 = {blv[n][2 * p], blv[n][2 * p + 1]};
                        f32x2 g = __builtin_elementwise_fma(ag, winv, bg2), l = __builtin_elementwise_fma(al, winv, bl2);
                        g[0] = fminf(g[0], 7.0f); g[1] = fminf(g[1], 7.0f);
                        l[0] = __builtin_amdgcn_fmed3f(l[0], -7.0f, 7.0f); l[1] = __builtin_amdgcn_fmed3f(l[1], -7.0f, 7.0f);
                        const f32x2 t = g * kexp;
                        f32x2 d = {__builtin_amdgcn_exp2f(t[0]), __builtin_amdgcn_exp2f(t[1])};
                        d = d + one2;
                        const f32x2 r = {__builtin_amdgcn_rcpf(d[0]), __builtin_amdgcn_rcpf(d[1])};
                        const f32x2 res = (g * r) * (l + one2);
                        o[n][2 * p] = res[0]; o[n][2 * p + 1] = res[1]; }
                *(u32x2*)(ACT + (size_t)row * DFF + f0) = pack8q(o[0], o[1]); }
    }
};
struct ExpertDown {
    static constexpr bool PERM = true;
    unsigned char* YS; const float* bdn;
    __device__ __forceinline__ void operator()(const Acc& acc, const Unit& u, int wr, int wc, int fr, int fq) const {
        const int row0 = u.pm * 256 + wr * 64 + fr, col0 = u.pn * 256 + wc * 32 + 8 * fq;
        f32x4 bv[2][2];
#pragma unroll
        for (int bj = 0; bj < 2; ++bj)
#pragma unroll
            for (int n = 0; n < 2; ++n) bv[bj][n] = *(const f32x4*)(bdn + (size_t)u.aux * DM + col0 + bj * 128 + 4 * n);
#pragma unroll
        for (int ai = 0; ai < 2; ++ai)
#pragma unroll
            for (int m = 0; m < 4; ++m)
#pragma unroll
                for (int bj = 0; bj < 2; ++bj)
                    *(u32x2*)(YS + (size_t)(row0 + ai * 128 + m * 16) * DM + col0 + bj * 128) = pack8q(acc[ai][bj][m][0] * WQ_INV + bv[bj][0], acc[ai][bj][m][1] * WQ_INV + bv[bj][1]);
    }
};
}

template <bool GATHER_>
struct MoeOrder {
    static constexpr bool GATHER = GATHER_;
    const LAS int* tab; const char* Abase; const char* Wbase; const int* rowtok; size_t wstride; int KB, nN, G, c;
    __device__ bool next(int i, pg8::Unit& u) const {
        const int npg = nN >> 2, x = c & 7, j = c >> 3, rbg = i * (G / nN) + 8 * (x / npg) + (j >> 2), pnl = 4 * (x % npg) + (j & 3), NB = tab[32];
        if (rbg >= NB) return false;
        int e = 0;
#pragma unroll
        for (int j = 1; j < NE; ++j) e += (tab[j] <= rbg) ? 1 : 0;
        u.pm = __builtin_amdgcn_readfirstlane(rbg); u.pn = __builtin_amdgcn_readfirstlane(pnl); u.aux = __builtin_amdgcn_readfirstlane(e); return true;
    }
    __device__ __forceinline__ int pitch_a() const { return KB; }
    __device__ __forceinline__ int pitch_b() const { return KB; }
    __device__ __forceinline__ const char* a_ptr(const pg8::Unit& u) const { return GATHER ? Abase : Abase + (size_t)u.pm * 256 * KB; }
    __device__ __forceinline__ const char* b_ptr(const pg8::Unit& u) const { return Wbase + (size_t)u.aux * wstride + (size_t)u.pn * 256 * KB; }
    __device__ __forceinline__ unsigned a_row(const pg8::Unit& u, int r) const {
        if (!GATHER) return (unsigned)r;
        const int slot = (u.pm - tab[u.aux]) * 256 + r;
        return slot < tab[64 + u.aux] ? (unsigned)rowtok[(size_t)u.aux * M + slot] : 0u;
    }
};

namespace fox {
constexpr float SCALE = 0.08838834764831845f;
constexpr float THR = 8.f;
constexpr int NW = 8, QBLK = 32, KVBLK = 64, QB = NW * QBLK, D = 128, PIT = 1024, OPIT = 2048;
constexpr int SHM_V = KVBLK * D * 2, SHM_K = KVBLK * D * 2;
constexpr int OFF_WS = 2 * SHM_V + 2 * SHM_K, OFF_CN = OFF_WS + NW * 96 * 4, OFF_VOTE = OFF_CN + SEQ * 4, LDS_BYTES = OFF_VOTE + 64;
constexpr float CUT = 18.0f;
typedef short s16x4 __attribute__((ext_vector_type(4)));
#define KSWZ(row, colB) ((row) * 256 + ((colB) ^ (((row) & 7) << 4)))
#define SBAR() __builtin_amdgcn_sched_barrier(0)
__device__ __forceinline__ int v_st(int k, int c) { const int kk = (k & ~0xC) | ((k & 4) << 1) | ((k & 8) >> 1); return ((kk >> 3) * 4 + (c >> 5)) * 512 + ((kk & 7) * 32 + (c & 31)) * 2; }
__device__ __forceinline__ int v_rd_base(int lane) { return ((lane & 3) << 3) | (((lane >> 2) & 3) << 6) | (((lane >> 4) & 1) << 5) | (((lane >> 5) & 1) << 8); }
constexpr int v_rd_off(int d0, int ks, int half) { return d0 * 512 + ks * 4096 + half * 2048; }
__device__ __forceinline__ int crow(int r, int hi) { return (r & 3) + 8 * (r >> 2) + 4 * hi; }
__device__ __forceinline__ void mask_tile(f32x16& p0, f32x16& p1, int dq) {
    const float NEG = -__builtin_inff();
#pragma unroll
    for (int r = 0; r < 16; ++r) {
        const int c = (r & 3) + 8 * (r >> 2);
        if (dq - c < 0) p0[r] = NEG;
        if (dq - c - 32 < 0) p1[r] = NEG;
    }
}
__device__ __forceinline__ void partialSM(f32x16& p0, f32x16& p1, float& m_reg, float& mn, float& alpha) {
    float pmax = p0[0];
#pragma unroll
    for (int r = 1; r < 16; ++r) pmax = fmaxf(pmax, p0[r]);
#pragma unroll
    for (int r = 0; r < 16; ++r) pmax = fmaxf(pmax, p1[r]);
    { auto rr = __builtin_amdgcn_permlane32_swap(__float_as_uint(pmax), __float_as_uint(pmax), false, false);
      pmax = fmaxf(__uint_as_float(rr[0]), __uint_as_float(rr[1])); }
    constexpr float C2 = 1.4426950408889634f * SCALE;
    if (__builtin_expect(__all((pmax - m_reg) * SCALE <= THR), 1)) { mn = m_reg; alpha = 1.f; }
    else { mn = fmaxf(m_reg, pmax); alpha = __builtin_amdgcn_exp2f((m_reg - mn) * C2); m_reg = mn; }
    const float mnL = -mn * C2;
#pragma unroll
    for (int r = 0; r < 16; ++r) p0[r] = fmaf(p0[r], C2, mnL);
#pragma unroll
    for (int r = 0; r < 16; ++r) p1[r] = fmaf(p1[r], C2, mnL);
#pragma unroll
    for (int r = 0; r < 16; ++r) p0[r] = __builtin_amdgcn_exp2f(p0[r]);
}
__device__ __forceinline__ void finishSM(f32x16& p0, f32x16& p1, float alpha, float& l_reg, f16x8& pa0, f16x8& pa1, f16x8& pa2, f16x8& pa3) {
#pragma unroll
    for (int r = 0; r < 16; ++r) p1[r] = __builtin_amdgcn_exp2f(p1[r]);
    float ps = 0;
#pragma unroll
    for (int r = 0; r < 16; ++r) ps += p0[r];
#pragma unroll
    for (int r = 0; r < 16; ++r) ps += p1[r];
    { auto rr = __builtin_amdgcn_permlane32_swap(__float_as_uint(ps), __float_as_uint(ps), false, false);
      ps = __uint_as_float(rr[0]) + __uint_as_float(rr[1]); }
    l_reg = l_reg * alpha + ps;
#define PK4(P, B_, OUT) do { unsigned a0 = pk2h(P[B_+0], P[B_+1]), a1 = pk2h(P[B_+2], P[B_+3]);                          \
        unsigned b0 = pk2h(P[B_+4], P[B_+5]), b1 = pk2h(P[B_+6], P[B_+7]);                                             \
        auto r0 = __builtin_amdgcn_permlane32_swap(a0, b0, false, false); auto r1 = __builtin_amdgcn_permlane32_swap(a1, b1, false, false); \
        u32x4 w = {r0[0], r1[0], r0[1], r1[1]}; OUT = __builtin_bit_cast(f16x8, w); } while (0)
    PK4(p0, 0, pa0); PK4(p0, 8, pa1); PK4(p1, 0, pa2); PK4(p1, 8, pa3);
#undef PK4
}
template <int KB>
__device__ __forceinline__ void qkt(f32x16& p0, f32x16& p1, const char* K_lds, int r32, int hi, const f16x8* qr, const LAS float* cnp) {
#pragma unroll
    for (int g = 0; g < 4; ++g) { const f32x4 a = *(const LAS f32x4*)(cnp + 8 * g), b = *(const LAS f32x4*)(cnp + 32 + 8 * g);
#pragma unroll
        for (int i = 0; i < 4; ++i) { p0[4 * g + i] = a[i]; p1[4 * g + i] = b[i]; } }
    const char* kb[4];
#pragma unroll
    for (int dd = 0; dd < 4; ++dd) kb[dd] = K_lds + KB * SHM_K + KSWZ(r32, (dd * 16 + hi * 8) * 2);
#pragma unroll
    for (int d0 = 0; d0 < 8; ++d0) { const char* a = kb[d0 & 3] + (d0 >> 2) * 128;
        f16x8 b0 = *reinterpret_cast<const f16x8*>(a);
        f16x8 b1 = *reinterpret_cast<const f16x8*>(a + 32 * 256);
        p0 = __builtin_amdgcn_mfma_f32_32x32x16_f16(b0, qr[d0], p0, 0, 0, 0);
        p1 = __builtin_amdgcn_mfma_f32_32x32x16_f16(b1, qr[d0], p1, 0, 0, 0); }
}
template <int VB>
__device__ __forceinline__ void pv_tile(f32x16* o, int vb0, f16x8 pa0, f16x8 pa1, f16x8 pa2, f16x8 pa3) {
#define TRRD(dst, off) asm volatile("ds_read_b64_tr_b16 %0, %1 offset:%2" : "=&v"(dst) : "v"(vb0), "i"(off) : "memory")
#define H8(l, h) __builtin_bit_cast(f16x8, (u32x4){__builtin_bit_cast(u32x2, l)[0], __builtin_bit_cast(u32x2, l)[1], __builtin_bit_cast(u32x2, h)[0], __builtin_bit_cast(u32x2, h)[1]})
#define PV_D0(d0) do { s16x4 l0, l1, l2, l3, h0, h1, h2, h3; constexpr int b_ = VB * SHM_V + v_rd_off(d0, 0, 0); \
        TRRD(l0, b_); TRRD(h0, b_ + 2048); TRRD(l1, b_ + 4096); TRRD(h1, b_ + 6144); TRRD(l2, b_ + 8192); TRRD(h2, b_ + 10240); TRRD(l3, b_ + 12288); TRRD(h3, b_ + 14336); \
        asm volatile("s_waitcnt lgkmcnt(0)" ::: "memory"); SBAR();   \
        o[d0] = __builtin_amdgcn_mfma_f32_32x32x16_f16(pa0, H8(l0, h0), o[d0], 0, 0, 0);   \
        o[d0] = __builtin_amdgcn_mfma_f32_32x32x16_f16(pa1, H8(l1, h1), o[d0], 0, 0, 0);   \
        o[d0] = __builtin_amdgcn_mfma_f32_32x32x16_f16(pa2, H8(l2, h2), o[d0], 0, 0, 0);   \
        o[d0] = __builtin_amdgcn_mfma_f32_32x32x16_f16(pa3, H8(l3, h3), o[d0], 0, 0, 0); } while (0)
    PV_D0(0); PV_D0(1); PV_D0(2); PV_D0(3);
#undef PV_D0
#undef H8
#undef TRRD
}
struct BlockRef { const f16* Q; const f16* K; const f16* V; f16* O; float* ss; int P0; float kb; };
struct Seam { f16x8 qr[8]; f16x8 st_v0, st_v1, st_k0, st_k1; };
#define ROW(p, k0, rr) ((p) + (size_t)((k0) + (rr)) * PIT + sc)
#define VMW() asm volatile("s_waitcnt vmcnt(0)" ::: "memory")
#define VMWN(n) asm volatile("s_waitcnt vmcnt(%0)" :: "i"(n) : "memory")
#define SLOAD_H(Kp, Vp, k0) do { S.st_v0 = *(const f16x8*)ROW(Vp, k0, sr); S.st_v1 = *(const f16x8*)ROW(Vp, k0, 32 + sr);              \
                         S.st_k0 = *(const f16x8*)ROW(Kp, k0, sr); S.st_k1 = *(const f16x8*)ROW(Kp, k0, 32 + sr); } while (0)
#define SWRITE_HK(bf) do { *(f16x8*)(K_lds + (bf) * SHM_K + kws) = S.st_k0; *(f16x8*)(K_lds + (bf) * SHM_K + kws + 32 * 256) = S.st_k1; } while (0)
#define SWRITE_HV(bf) do { *(f16x8*)(V_lds + (bf) * SHM_V + vst0) = S.st_v0; *(f16x8*)(V_lds + (bf) * SHM_V + vst1) = S.st_v1; } while (0)
#define SWRITE_H(bf) do { SWRITE_HV(bf); SWRITE_HK(bf); } while (0)
__device__ __forceinline__ int first_kb(int P0) { return P0 + QB - KVBLK; }
__device__ __forceinline__ void prime(const BlockRef& cur, const float* cneg, char* lds, Seam& S) {
    const int tid = opaque_tid(), wid = __builtin_amdgcn_readfirstlane(tid >> 6), lane = tid & 63, r32 = lane & 31, hi = lane >> 5;
    const int sr = tid >> 4, sc = (tid & 15) * 8, kws = KSWZ(sr, sc * 2); char* K_lds = lds + 2 * SHM_V;
    const int kb0 = first_kb(cur.P0);
#pragma unroll
    for (int d0 = 0; d0 < 8; ++d0) S.qr[d0] = *(const f16x8*)(cur.Q + (size_t)(cur.P0 + wid * QBLK + r32) * PIT + d0 * 16 + hi * 8);
    SLOAD_H(cur.K, cur.V, kb0);
    { float* cn = (float*)(lds + OFF_CN);
#pragma unroll
      for (int j = 0; j < 4; ++j) *(f32x4*)(cn + (tid + 512 * j) * 4) = *(const f32x4*)(cneg + (tid + 512 * j) * 4); }
    VMW(); SWRITE_HK(0);
    __syncthreads();
}
__device__ __forceinline__ void block(const BlockRef& cur, const BlockRef& nxt, int tokbase, char* lds, Seam& S) {
    const int tid = opaque_tid(), wid = __builtin_amdgcn_readfirstlane(tid >> 6), lane = tid & 63, r32 = lane & 31, hi = lane >> 5;
    const int NT = cur.P0 / KVBLK + QB / KVBLK;
    const int kbn = first_kb(nxt.P0);
    const int qlo = cur.P0 + wid * QBLK, qm = qlo + r32 - 4 * hi;
    char* V_lds = lds; char* K_lds = lds + 2 * SHM_V;
    float* ws = (float*)(lds + OFF_WS) + wid * 96; float* li_l = ws, * al_l = ws + 32, * qb_l = ws + 64;
    const LAS float* cn = (const LAS float*)(LAS char*)(lds + OFF_CN) + 4 * hi;
    float m_reg = -1e30f, l_reg = 0; f32x16 o[4] = {};
    const int sr = tid >> 4, sc = (tid & 15) * 8, vst0 = v_st(sr, sc), vst1 = v_st(32 + sr, sc), kws = KSWZ(sr, sc * 2);
    const int vb0 = (int)(uintptr_t)V_lds + v_rd_base(lane);
    { float s2 = 0.f;
#pragma unroll
      for (int d0 = 0; d0 < 8; ++d0)
#pragma unroll
          for (int e = 0; e < 8; ++e) { const float x = (float)S.qr[d0][e]; s2 += x * x; }
      auto rr = __builtin_amdgcn_permlane32_swap(__float_as_uint(s2), __float_as_uint(s2), false, false);
      if (hi == 0) qb_l[r32] = sqrtf(__uint_as_float(rr[0]) + __uint_as_float(rr[1])) * cur.kb; }
    volatile LAS unsigned* vote = (volatile LAS unsigned*)(LAS char*)(lds + OFF_VOTE);
    const f16* Kh = cur.K; const f16* Vh = cur.V;
#define RESC(a) do { if (__any((a) < 1.f)) { if (hi == 0) al_l[r32] = (a); asm volatile("s_waitcnt lgkmcnt(0)" ::: "memory");              \
                     for (int d_ = 0; d_ < 4; ++d_) for (int r = 0; r < 16; ++r) o[d_][r] *= al_l[crow(r, hi)]; } } while (0)
#define KBASE(t) ((NT - 1 - (t)) * KVBLK)
#define MASKT(P0_, P1_, t) do { const int kb_ = KBASE(t); if (kb_ + KVBLK - 1 > qlo) mask_tile(P0_, P1_, qm - kb_); } while (0)
    constexpr int NQL = 8;
#define SEAM_K0() do { VMWN(NQL); SWRITE_HK(0); SBAR(); } while (0)
    f32x16 pA0, pA1, pB0, pB1; float mnA, mnB, alA, alB; f16x8 pa0, pa1, pa2, pa3;
    SWRITE_HV(0); SBAR();
    if (NT > 1) { SLOAD_H(Kh, Vh, KBASE(1)); }
    SBAR(); qkt<0>(pA0, pA1, K_lds, r32, hi, S.qr, cn + KBASE(0));
    MASKT(pA0, pA1, 0); partialSM(pA0, pA1, m_reg, mnA, alA);
    if (NT > 1) { VMW(); SWRITE_H(1); }
    __syncthreads();
#define HALF_STEP(PX0, PX1, mnX, alX, PY0, PY1, alY, t, KB, VB, SB) do {                                                      \
        SBAR(); qkt<KB>(PX0, PX1, K_lds, r32, hi, S.qr, cn + KBASE(t));                                                       \
        finishSM(PY0, PY1, alY, l_reg, pa0, pa1, pa2, pa3); SBAR();                                                           \
        if ((t) + 1 < NT) { SLOAD_H(Kh, Vh, KBASE((t) + 1)); SBAR(); }                                                        \
        pv_tile<VB>(o, vb0, pa0, pa1, pa2, pa3); MASKT(PX0, PX1, (t)); partialSM(PX0, PX1, m_reg, mnX, alX);                  \
        __syncthreads();                                                                                                      \
        if ((t) + 1 < NT) { VMW(); SWRITE_H(SB); }                                                                            \
        RESC(alX); __syncthreads(); } while (0)
    bool broke = false;
    for (int t = 1; t + 1 < NT; t += 2) {
        HALF_STEP(pB0, pB1, mnB, alB, pA0, pA1, alA, t, 1, 0, 0);
        HALF_STEP(pA0, pA1, mnA, alA, pB0, pB1, alB, t + 1, 0, 1, 1);
        if (t + 2 < NT) {
            const float cl = *((const LAS float*)(LAS char*)(lds + OFF_CN) + KBASE(t + 2) + KVBLK - 1);
            const bool can = __all((qb_l[r32] + cl - m_reg) * SCALE < -CUT);
            if (lane == 0) vote[wid] = can ? 1u : 0u;
            asm volatile("s_waitcnt lgkmcnt(0)" ::: "memory"); __syncthreads();
            unsigned all_ = 1u;
#pragma unroll
            for (int w_ = 0; w_ < NW; ++w_) all_ &= vote[w_];
            __syncthreads();
            if (all_) { broke = true; break; }
        }
    }
    const bool even = !broke;
    if (even) { SBAR(); qkt<1>(pB0, pB1, K_lds, r32, hi, S.qr, cn + KBASE(NT - 1)); SBAR(); }
    SLOAD_H(nxt.K, nxt.V, kbn); SBAR();
#pragma unroll
    for (int d0 = 0; d0 < 8; ++d0) S.qr[d0] = *(const f16x8*)(nxt.Q + (size_t)(nxt.P0 + wid * QBLK + r32) * PIT + d0 * 16 + hi * 8);
    SBAR();
    finishSM(pA0, pA1, alA, l_reg, pa0, pa1, pa2, pa3); SBAR();
    pv_tile<0>(o, vb0, pa0, pa1, pa2, pa3);
    if (even) { MASKT(pB0, pB1, NT - 1); partialSM(pB0, pB1, m_reg, mnB, alB); __syncthreads(); RESC(alB);
        finishSM(pB0, pB1, alB, l_reg, pa0, pa1, pa2, pa3); SBAR(); pv_tile<1>(o, vb0, pa0, pa1, pa2, pa3); }
    SBAR(); SEAM_K0();
    if (hi == 0) li_l[r32] = l_reg; asm volatile("s_waitcnt lgkmcnt(0)" ::: "memory");
    f16* Ow = cur.O + (size_t)(cur.P0 + wid * QBLK) * OPIT;
#pragma unroll
    for (int r = 0; r < 16; ++r) { const int orow = crow(r, hi); const float rl = __builtin_amdgcn_rcpf(li_l[orow]); float sq = 0.f;
#pragma unroll
        for (int d0 = 0; d0 < 4; ++d0) { const float v = o[d0][r] * rl; sq += v * v;
            const float vn = __shfl_xor(v, 1);
            if ((r32 & 1) == 0) *(unsigned*)(Ow + (size_t)orow * OPIT + d0 * 32 + r32) = pk2h(v, vn); }
        sq += __shfl_xor(sq, 1); sq += __shfl_xor(sq, 2); sq += __shfl_xor(sq, 4); sq += __shfl_xor(sq, 8); sq += __shfl_xor(sq, 16);
        if (r32 == 0) cur.ss[(size_t)(tokbase + cur.P0 + wid * QBLK + orow) * 8] = sq; }
    __syncthreads();
#undef RESC
#undef KBASE
#undef MASKT
#undef SEAM_K0
#undef HALF_STEP
}
#undef ROW
#undef VMW
#undef VMWN
#undef SLOAD_H
#undef SWRITE_HK
#undef SWRITE_HV
#undef SWRITE_H
__device__ __forceinline__ void item(int bh, int x, const f16* Q, const f16* K, const f16* V, f16* MIX, float* ss_att, const float* cneg, const float* kmax, char* lds) {
    const int b = bh >> 3, h = bh & 7; const size_t base = (size_t)b * SEQ * PIT + h * AD;
    BlockRef r0, r1;
    r0.kb = sqrtf((kmax[bh * 4] + kmax[bh * 4 + 1] + kmax[bh * 4 + 2] + kmax[bh * 4 + 3]) * 1.004f);
    r0.Q = Q + base; r0.K = K + base; r0.V = V + base; r0.O = MIX + (size_t)b * SEQ * OPIT + h * AD; r0.ss = ss_att + h; r0.P0 = x * QB;
    r1 = r0; r1.P0 = (SEQ / QB - 1 - x) * QB;
    Seam S;
    prime(r0, cneg + (size_t)bh * SEQ, lds, S);
    BlockRef rz = r0; rz.P0 = 0;
    block(r0, r1, b * SEQ, lds, S);
    block(r1, rz, b * SEQ, lds, S);
}
}

namespace xat {
using namespace fox;
constexpr int CHB = 65536;
constexpr int LDS_BYTES = 2 * CHB + NW * 64 * 4;
__device__ __forceinline__ void unit(int b, int hc, int qb, const f16* QC, const f16* KVC, f16* OC, char* lds) {
    const int tid = opaque_tid(), wid = __builtin_amdgcn_readfirstlane(tid >> 6), lane = tid & 63, r32 = lane & 31, hi = lane >> 5;
    const int sr = tid >> 4, sc = (tid & 15) * 8, kws = KSWZ(sr, sc * 2), vst0 = v_st(sr, sc), vst1 = v_st(32 + sr, sc);
    const int row = b * SEQ + qb * QB + wid * QBLK + r32;
    const f16* Qrow = QC + (size_t)row * DM + hc * CD + hi * 8;
    const f16* Kb = KVC + (size_t)(b * MEML) * (2 * DM) + hc * CD + sc;
    const f16* Vb = Kb + DM;
    float* li_l = (float*)(lds + 2 * CHB) + wid * 64;
    f16x8 st[8];
#define XLOAD(P, ch) do { _Pragma("unroll") for (int kt = 0; kt < 4; ++kt) { st[2 * kt] = *(const f16x8*)((P) + (size_t)(kt * 64 + sr) * (2 * DM) + (ch) * 128); \
                                                                            st[2 * kt + 1] = *(const f16x8*)((P) + (size_t)(kt * 64 + 32 + sr) * (2 * DM) + (ch) * 128); } } while (0)
#define XWRITE_K(buf) do { _Pragma("unroll") for (int kt = 0; kt < 4; ++kt) { *(f16x8*)(lds + (buf) * CHB + kt * 16384 + kws) = st[2 * kt]; *(f16x8*)(lds + (buf) * CHB + kt * 16384 + kws + 32 * 256) = st[2 * kt + 1]; } } while (0)
#define XWRITE_V(buf) do { _Pragma("unroll") for (int kt = 0; kt < 4; ++kt) { *(f16x8*)(lds + (buf) * CHB + kt * 16384 + vst0) = st[2 * kt]; *(f16x8*)(lds + (buf) * CHB + kt * 16384 + vst1) = st[2 * kt + 1]; } } while (0)
    f32x16 p[4][2];
#pragma unroll
    for (int kt = 0; kt < 4; ++kt) { p[kt][0] = f32x16{}; p[kt][1] = f32x16{}; }
    XLOAD(Kb, 0); asm volatile("s_waitcnt vmcnt(0)" ::: "memory"); XWRITE_K(0); __syncthreads();
#pragma unroll 1
    for (int c = 0; c < 4; ++c) {
        f16x8 qr[8];
#pragma unroll
        for (int d0 = 0; d0 < 8; ++d0) qr[d0] = *(const f16x8*)(Qrow + c * 128 + d0 * 16);
        if (c < 3) XLOAD(Kb, c + 1); else XLOAD(Vb, 0);
        const char* kbuf = lds + (c & 1) * CHB;
#pragma unroll
        for (int kt = 0; kt < 4; ++kt) {
            const char* kb[4];
#pragma unroll
            for (int dd = 0; dd < 4; ++dd) kb[dd] = kbuf + kt * 16384 + KSWZ(r32, (dd * 16 + hi * 8) * 2);
#pragma unroll
            for (int d0 = 0; d0 < 8; ++d0) { const char* a = kb[d0 & 3] + (d0 >> 2) * 128;
                const f16x8 b0 = *reinterpret_cast<const f16x8*>(a), b1 = *reinterpret_cast<const f16x8*>(a + 32 * 256);
                p[kt][0] = __builtin_amdgcn_mfma_f32_32x32x16_f16(b0, qr[d0], p[kt][0], 0, 0, 0);
                p[kt][1] = __builtin_amdgcn_mfma_f32_32x32x16_f16(b1, qr[d0], p[kt][1], 0, 0, 0); }
        }
        asm volatile("s_waitcnt vmcnt(0)" ::: "memory");
        if (c < 3) XWRITE_K((c + 1) & 1); else XWRITE_V(0);
        __syncthreads();
    }
    float mx = p[0][0][0];
#pragma unroll
    for (int kt = 0; kt < 4; ++kt)
#pragma unroll
        for (int j = 0; j < 2; ++j)
#pragma unroll
            for (int r = 0; r < 16; ++r) mx = fmaxf(mx, p[kt][j][r]);
    { auto rr = __builtin_amdgcn_permlane32_swap(__float_as_uint(mx), __float_as_uint(mx), false, false); mx = fmaxf(__uint_as_float(rr[0]), __uint_as_float(rr[1])); }
    float ps = 0.f; const float mL = -mx * 1.4426950408889634f;
#pragma unroll
    for (int kt = 0; kt < 4; ++kt)
#pragma unroll
        for (int j = 0; j < 2; ++j)
#pragma unroll
            for (int r = 0; r < 16; ++r) { const float e = __builtin_amdgcn_exp2f(fmaf(p[kt][j][r], 1.4426950408889634f, mL)); p[kt][j][r] = e; ps += e; }
    { auto rr = __builtin_amdgcn_permlane32_swap(__float_as_uint(ps), __float_as_uint(ps), false, false); ps = __uint_as_float(rr[0]) + __uint_as_float(rr[1]); }
    f16x8 pa[4][4];
#define PK4(P, B_, OUT) do { unsigned a0 = pk2h(P[B_+0], P[B_+1]), a1 = pk2h(P[B_+2], P[B_+3]);                          \
        unsigned b0 = pk2h(P[B_+4], P[B_+5]), b1 = pk2h(P[B_+6], P[B_+7]);                                             \
        auto r0 = __builtin_amdgcn_permlane32_swap(a0, b0, false, false); auto r1 = __builtin_amdgcn_permlane32_swap(a1, b1, false, false); \
        u32x4 w = {r0[0], r1[0], r0[1], r1[1]}; OUT = __builtin_bit_cast(f16x8, w); } while (0)
#pragma unroll
    for (int kt = 0; kt < 4; ++kt) { PK4(p[kt][0], 0, pa[kt][0]); PK4(p[kt][0], 8, pa[kt][1]); PK4(p[kt][1], 0, pa[kt][2]); PK4(p[kt][1], 8, pa[kt][3]); }
#undef PK4
    if (hi == 0) li_l[r32] = ps;
    asm volatile("s_waitcnt lgkmcnt(0)" ::: "memory");
    float rl[16];
#pragma unroll
    for (int r = 0; r < 16; ++r) rl[r] = __builtin_amdgcn_rcpf(li_l[crow(r, hi)]);
    f16* Ow = OC + (size_t)(b * SEQ + qb * QB + wid * QBLK) * DM + hc * CD;
#pragma unroll 1
    for (int v = 0; v < 4; ++v) {
        if (v < 3) XLOAD(Vb, v + 1);
        f32x16 o[4] = {};
        const int vb0 = (int)(uintptr_t)lds + (v & 1) * CHB + v_rd_base(lane);
        pv_tile<0>(o, vb0, pa[0][0], pa[0][1], pa[0][2], pa[0][3]);
        pv_tile<1>(o, vb0, pa[1][0], pa[1][1], pa[1][2], pa[1][3]);
        pv_tile<2>(o, vb0, pa[2][0], pa[2][1], pa[2][2], pa[2][3]);
        pv_tile<3>(o, vb0, pa[3][0], pa[3][1], pa[3][2], pa[3][3]);
#pragma unroll
        for (int r = 0; r < 16; ++r) { const int orow = crow(r, hi);
#pragma unroll
            for (int d0 = 0; d0 < 4; ++d0) { const float val = o[d0][r] * rl[r]; const float vn = __shfl_xor(val, 1);
                if ((r32 & 1) == 0) *(unsigned*)(Ow + (size_t)orow * DM + v * 128 + d0 * 32 + r32) = pk2h(val, vn); } }
        if (v < 3) { asm volatile("s_waitcnt vmcnt(0)" ::: "memory"); XWRITE_V((v + 1) & 1); }
        __syncthreads();
    }
#undef XLOAD
#undef XWRITE_K
#undef XWRITE_V
}
}
#undef KSWZ
#undef SBAR

namespace ssm {
constexpr int KT_BYTES = 65 * 512;
constexpr int UST = 2064;
constexpr int OFF_U1 = 0, OFF_X = 0, OFF_KT = 34816, OFF_S = 68096, OFF_U3 = 68096, LDS_BYTES = 134144;
static_assert(OFF_X + 128 * 136 * 2 <= OFF_KT && OFF_KT + KT_BYTES <= OFF_S && OFF_S + 128 * 129 * 4 <= LDS_BYTES && OFF_U3 + 32 * UST <= LDS_BYTES && OFF_U1 + 32 * UST <= OFF_S, "ssm LDS map");
__device__ __forceinline__ float gelu_tanh(float x) {
    const float u = 0.7978845608028654f * (x + 0.044715f * x * x * x);
    const float e = __expf(2.0f * u);
    const float th = 1.0f - 2.0f * __builtin_amdgcn_rcpf(e + 1.0f);
    return 0.5f * x * (1.0f + th);
}
__device__ __forceinline__ void stage_u(const f16* src, LAS unsigned char* dst, int tid) {
    u32x4 v[8];
#pragma unroll
    for (int j = 0; j < 8; ++j) v[j] = *(const u32x4*)((const char*)src + (size_t)(tid + 512 * j) * 16);
#pragma unroll
    for (int j = 0; j < 8; ++j) { const int e = tid + 512 * j; *(LAS u32x4*)(dst + (e >> 7) * UST + (e & 127) * 16) = v[j]; }
}
__device__ __forceinline__ void unit(int b, int g, int half, const f16* U, const f16* KT, const f16* MIN, const f16* MOUT, const float* L64, f16* G, LAS unsigned char* lds) {
    const int tid = opaque_tid(), wid = __builtin_amdgcn_readfirstlane(tid >> 6), lane = tid & 63, n16 = lane & 15, kq = lane >> 4;
    const f16* Ug = U + ((size_t)(b * NG + g) * SEQ) * SG;
    const f16* KTg = KT + (size_t)g * (65 * 256); const f16* MINg = MIN + (size_t)g * (128 * 1024); const f16* MOUTg = MOUT + (size_t)g * (1024 * 128);
    LAS float* s_l = (LAS float*)(lds + OFF_S); LAS f16* x_l = (LAS f16*)(lds + OFF_X);
    const int ngrp = 2 * (half + 1);
    const int boff = n16 * UST + ((kq >> 1) * 16 + 8 * (kq & 1)) * 2;
    {
        f16x8 afr[32];
        const f16* arow = MINg + (size_t)(wid * 16 + n16) * 1024 + 8 * kq;
#pragma unroll
        for (int sp = 0; sp < 32; ++sp) afr[sp] = *(const f16x8*)(arow + sp * 32);
#pragma unroll 1
        for (int grp = 0; grp < ngrp; ++grp) {
            stage_u(Ug + (size_t)grp * 32 * 64 * SG, lds + OFF_U1, tid);
            __syncthreads();
            f32x4 acc[2] = {(f32x4){0.f, 0.f, 0.f, 0.f}, (f32x4){0.f, 0.f, 0.f, 0.f}};
#pragma unroll
            for (int sp = 0; sp < 32; ++sp)
#pragma unroll
                for (int cb = 0; cb < 2; ++cb) { const f16x8 bf = *(const LAS f16x8*)(lds + OFF_U1 + boff + cb * 16 * UST + sp * 64);
                    acc[cb] = __builtin_amdgcn_mfma_f32_16x16x32_f16(afr[sp], bf, acc[cb], 0, 0, 0); }
#pragma unroll
            for (int cb = 0; cb < 2; ++cb)
#pragma unroll
                for (int r = 0; r < 4; ++r) s_l[((grp * 2 + cb) * 16 + n16) * 129 + wid * 16 + 4 * kq + r] = acc[cb][r];
            __syncthreads();
        }
    }
    if (tid < 64) {
        const f32x2 l = *(const f32x2*)(L64 + (size_t)(g * 64 + tid) * 2);
        float xr = 0.f, xi = 0.f;
        for (int c = 0; c < 32 * ngrp; ++c) {
            x_l[c * 136 + tid] = (f16)xr; x_l[c * 136 + 64 + tid] = (f16)xi;
            const float sr = s_l[c * 129 + tid], si = s_l[c * 129 + 64 + tid];
            const float nr = l[0] * xr - l[1] * xi + sr, ni = l[0] * xi + l[1] * xr + si;
            xr = nr; xi = ni;
        }
    } else {
        for (int i = tid - 64; i < KT_BYTES / 16; i += 448) *(LAS u32x4*)(lds + OFF_KT + i * 16) = *(const u32x4*)((const char*)KTg + i * 16);
    }
    __syncthreads();
    const LAS f16* ktl = (const LAS f16*)(lds + OFF_KT) + n16 * 16 + 8 * (kq & 1);
    const int lagoff = 1 - (kq >> 1);
#pragma unroll 1
    for (int pass = 2 * half; pass < 2 * half + 2; ++pass) {
        stage_u(Ug + (size_t)pass * 32 * 64 * SG, lds + OFF_U3, tid);
        __syncthreads();
        f32x4 acc[8][2];
#pragma unroll
        for (int ti = 0; ti < 8; ++ti) { acc[ti][0] = (f32x4){0.f, 0.f, 0.f, 0.f}; acc[ti][1] = (f32x4){0.f, 0.f, 0.f, 0.f}; }
#define SSM_RANGE(m) do { const int hi_ = ((wid + 8 * (m)) >> 1) < 31 ? ((wid + 8 * (m)) >> 1) : 31; \
        _Pragma("unroll 2") for (; sp <= hi_; ++sp) { const int s0 = 2 * sp; \
            const f16x8 b0 = *(const LAS f16x8*)(lds + OFF_U3 + boff + sp * 64); \
            const f16x8 b1 = *(const LAS f16x8*)(lds + OFF_U3 + boff + 16 * UST + sp * 64); \
            _Pragma("unroll") for (int ti = (m); ti < 8; ++ti) { const int t = wid + 8 * ti; \
                int li = t - s0 + lagoff; li = li < 0 ? 0 : li; \
                const f16x8 a = *(const LAS f16x8*)(ktl + li * 256); \
                acc[ti][0] = __builtin_amdgcn_mfma_f32_16x16x32_f16(a, b0, acc[ti][0], 0, 0, 0); \
                acc[ti][1] = __builtin_amdgcn_mfma_f32_16x16x32_f16(a, b1, acc[ti][1], 0, 0, 0); } } } while (0)
        { int sp = 0;
          SSM_RANGE(0); SSM_RANGE(1); SSM_RANGE(2); SSM_RANGE(3); SSM_RANGE(4); SSM_RANGE(5); SSM_RANGE(6); SSM_RANGE(7); }
#undef SSM_RANGE
#pragma unroll
        for (int ks = 0; ks < 4; ++ks) {
            const f16x8 b0 = *(const LAS f16x8*)(x_l + ((pass * 2 + 0) * 16 + n16) * 136 + ks * 32 + 8 * kq);
            const f16x8 b1 = *(const LAS f16x8*)(x_l + ((pass * 2 + 1) * 16 + n16) * 136 + ks * 32 + 8 * kq);
#pragma unroll
            for (int ti = 0; ti < 8; ++ti) { const int t = wid + 8 * ti;
                const f16x8 a = *(const f16x8*)(MOUTg + (size_t)(t * 16 + n16) * 128 + ks * 32 + 8 * kq);
                acc[ti][0] = __builtin_amdgcn_mfma_f32_16x16x32_f16(a, b0, acc[ti][0], 0, 0, 0);
                acc[ti][1] = __builtin_amdgcn_mfma_f32_16x16x32_f16(a, b1, acc[ti][1], 0, 0, 0); }
        }
#pragma unroll
        for (int ti = 0; ti < 8; ++ti)
#pragma unroll
            for (int j = 0; j < 2; ++j) { const int t = wid + 8 * ti, c = (pass * 2 + j) * 16 + n16; const size_t tok = (size_t)b * SEQ + 64 * c + t;
                const f32x4 y = acc[ti][j];
                u32x2 w = {pk2h(gelu_tanh(y[0]), gelu_tanh(y[1])), pk2h(gelu_tanh(y[2]), gelu_tanh(y[3]))};
                *(u32x2*)(G + tok * SSMW + g * SG + 4 * kq) = w; }
        __syncthreads();
    }
}
}

constexpr size_t MiB = 1u << 20;
constexpr size_t WS_CTL = 0, CTL_ZERO_BYTES = 65536;
constexpr int CW_BAR = 1024, CW_CNT = CW_BAR + XCD_BAR_WORDS, CNT_STRIDE = 32, CW_KMAX = 15424, CW_CLAIM = 15488;
static_assert(CW_BAR + 4 * XCD_BAR_WORDS <= CW_KMAX && NE * CNT_STRIDE <= XCD_BAR_WORDS && (CW_CLAIM + 128) * 4 <= (int)CTL_ZERO_BYTES, "CTL map");
constexpr size_t WS_WIN = 1 * MiB;
constexpr size_t WS_WGLU = WS_WIN + (size_t)4096 * 2048 * 2;
constexpr size_t WS_WOUT = WS_WGLU + (size_t)1024 * 1024 * 2;
constexpr size_t WS_WCQ = WS_WOUT + (size_t)2048 * 2048 * 2;
constexpr size_t WS_WCKV = WS_WCQ + (size_t)2048 * 2048 * 2;
constexpr size_t WS_WCO = WS_WCKV + (size_t)4096 * 2048 * 2;
constexpr size_t WS_WR = WS_WCO + (size_t)2048 * 2048 * 2;
constexpr size_t WS_KT = WS_WR + (size_t)32 * 2048 * 2;
constexpr size_t WS_MIN = WS_KT + (size_t)64 * 65 * 256 * 2;
constexpr size_t WS_MOUT = WS_MIN + (size_t)64 * 128 * 1024 * 2;
constexpr size_t WS_L64 = WS_MOUT + (size_t)64 * 1024 * 128 * 2;
constexpr size_t WS_FL = WS_L64 + (size_t)64 * 64 * 8;
constexpr size_t WS_CNEG = WS_FL + (size_t)M * 8 * 4;
constexpr size_t WS_ROUTE = WS_CNEG + (size_t)16 * SEQ * 4;
constexpr size_t WS_ROWTOK = WS_ROUTE + (size_t)M * 4 * 16;
constexpr size_t WS_MEMN = WS_ROWTOK + (size_t)NE * M * 4;
constexpr size_t WS_KVC = WS_MEMN + (size_t)512 * 2048 * 2;
constexpr size_t WS_SSATT = WS_KVC + (size_t)512 * 4096 * 2;
constexpr size_t WS_SSSSM = WS_SSATT + (size_t)M * 8 * 4;
constexpr size_t WS_SSH = WS_SSSSM + (size_t)M * 16 * 4;
constexpr size_t WS_SSH2 = WS_SSH + (size_t)M * 32 * 4;
constexpr size_t WS_XN = 128 * MiB;
constexpr size_t WS_U = WS_XN + 64 * MiB;
constexpr size_t WS_Q = WS_U + 32 * MiB, WS_K = WS_Q + 32 * MiB, WS_V = WS_K + 32 * MiB;
constexpr size_t WS_G = WS_V + 32 * MiB;
constexpr size_t WS_MIX = WS_G + 32 * MiB;
constexpr size_t WS_H = WS_MIX + 64 * MiB;
constexpr size_t WS_HA = WS_H + 128 * MiB;
constexpr size_t WS_QC = WS_HA + 64 * MiB;
constexpr size_t WS_PB = WS_QC, WS_WKT = WS_QC + 32 * MiB, WS_VWT = WS_QC + 40 * MiB;
constexpr size_t WS_OC = WS_QC + 64 * MiB, WS_H8 = WS_OC;
constexpr size_t WS_X2N = WS_OC + 64 * MiB;
constexpr size_t WS_ACT = WS_X2N + 64 * MiB;
constexpr size_t WS_YS = WS_ACT + 288 * MiB;
constexpr size_t WS_WGU = WS_YS + 288 * MiB;
constexpr size_t WS_WDN = WS_WGU + 512 * MiB;
constexpr size_t WS_END = WS_WDN + 256 * MiB;
static_assert(WS_SSH2 + (size_t)M * 32 * 4 <= WS_XN, "small tables fit below 128 MiB");

constexpr int RING_BYTES = 134144 + 0;
constexpr int RING_CAP = 135168;
constexpr int MISC_OFF = RING_CAP;
constexpr int MOE_TAB_OFF = MISC_OFF + 64;
constexpr int XCH_OFF = MISC_OFF + 2048;
constexpr int MSC_OFF = MISC_OFF + 1024;
constexpr int LDS_BYTES = 147456;
static_assert(ssm::LDS_BYTES <= RING_CAP && xat::LDS_BYTES <= RING_CAP && fox::LDS_BYTES <= RING_CAP && pg8::STAGE_BYTES <= RING_CAP && MOE_TAB_OFF + 128 * 4 <= MSC_OFF && MSC_OFF + 1024 <= XCH_OFF && XCH_OFF + 8192 <= LDS_BYTES, "LDS map");

constexpr int NWAVES = 8;

__device__ __forceinline__ void titem_load(f32x4 (&v)[16], const float* W, int ldw, int k0, int c0, int lane) {
    const int kr = lane >> 4, n4 = (lane & 15) * 4;
#pragma unroll
    for (int i = 0; i < 16; ++i) v[i] = __builtin_nontemporal_load((const f32x4*)(W + (size_t)(k0 + 4 * i + kr) * ldw + c0 + n4));
}
template <bool Q8, class RowMap>
__device__ __forceinline__ void titem_store(const f32x4 (&v)[16], int k0, int c0, void* WT, int K, const RowMap& rm, const float* kscale, float mul, LAS float* scr, int lane) {
    const int kr = lane >> 4, n4 = (lane & 15) * 4;
#pragma unroll
    for (int i = 0; i < 16; ++i) { LAS float* d = scr + (4 * i + kr) * 65 + n4; d[0] = v[i][0]; d[1] = v[i][1]; d[2] = v[i][2]; d[3] = v[i][3]; }
    LDS_WAIT(); asm volatile("" ::: "memory");
    const int c = lane & 7;
    float ks[8];
#pragma unroll
    for (int j = 0; j < 8; ++j) ks[j] = kscale ? kscale[k0 + 8 * c + j] * mul : mul;
#pragma unroll
    for (int j = 0; j < 8; ++j) { const int n = (lane >> 3) + 8 * j; const LAS float* s = scr + (8 * c) * 65 + n;
        if constexpr (Q8) { *(u32x2*)((unsigned char*)WT + (size_t)rm(c0 + n) * K + k0 + 8 * c) =
                pack8q((f32x4){s[0 * 65] * ks[0], s[1 * 65] * ks[1], s[2 * 65] * ks[2], s[3 * 65] * ks[3]}, (f32x4){s[4 * 65] * ks[4], s[5 * 65] * ks[5], s[6 * 65] * ks[6], s[7 * 65] * ks[7]}); }
        else { u32x4 o; o.x = pk2h(s[0 * 65] * ks[0], s[1 * 65] * ks[1]); o.y = pk2h(s[2 * 65] * ks[2], s[3 * 65] * ks[3]); o.z = pk2h(s[4 * 65] * ks[4], s[5 * 65] * ks[5]); o.w = pk2h(s[6 * 65] * ks[6], s[7 * 65] * ks[7]);
            *(u32x4*)((f16*)WT + (size_t)rm(c0 + n) * K + k0 + 8 * c) = o; } }
    LDS_WAIT(); asm volatile("" ::: "memory");
}
__device__ __forceinline__ void qitem_load(f32x4 (&v)[16], const float* W, int ldw, int k0, int c0, int lane) {
    const int kr = lane >> 3, n4 = (lane & 7) * 4;
#pragma unroll
    for (int i = 0; i < 16; ++i) v[i] = __builtin_nontemporal_load((const f32x4*)(W + (size_t)(k0 + 8 * i + kr) * ldw + c0 + n4));
}
__device__ __forceinline__ void tr4x4_b8(unsigned a, unsigned b, unsigned c, unsigned d, unsigned (&o)[4]) {
    const unsigned ab0 = __builtin_amdgcn_perm(b, a, 0x05010400), ab1 = __builtin_amdgcn_perm(b, a, 0x07030602);
    const unsigned cd0 = __builtin_amdgcn_perm(d, c, 0x05010400), cd1 = __builtin_amdgcn_perm(d, c, 0x07030602);
    o[0] = __builtin_amdgcn_perm(cd0, ab0, 0x05040100); o[1] = __builtin_amdgcn_perm(cd0, ab0, 0x07060302);
    o[2] = __builtin_amdgcn_perm(cd1, ab1, 0x05040100); o[3] = __builtin_amdgcn_perm(cd1, ab1, 0x07060302);
}
template <class RowMap>
__device__ __forceinline__ void qitem_store(const f32x4 (&v)[16], int k0, int c0, unsigned char* WT, int K, const RowMap& rm, float mul, LAS float* scr, int lane) {
    LAS unsigned* t8 = (LAS unsigned*)scr;
    const int kr = lane >> 3, nq = lane & 7;
#pragma unroll
    for (int i = 0; i < 16; ++i) { const f32x4 x = v[i] * mul; unsigned w = 0;
        w = __builtin_amdgcn_cvt_pk_fp8_f32(x[0], x[1], w, false); w = __builtin_amdgcn_cvt_pk_fp8_f32(x[2], x[3], w, true);
        t8[(8 * i + kr) * 9 + nq] = w; }
    LDS_WAIT(); asm volatile("" ::: "memory");
    const int ng = lane & 7, c = lane >> 3;
    unsigned out[4][4];
#pragma unroll
    for (int blk = 0; blk < 4; ++blk) { const LAS unsigned* p = t8 + (16 * c + 4 * blk) * 9 + ng; unsigned o[4];
        tr4x4_b8(p[0], p[9], p[18], p[27], o);
#pragma unroll
        for (int j = 0; j < 4; ++j) out[j][blk] = o[j]; }
#pragma unroll
    for (int j = 0; j < 4; ++j) *(u32x4*)(WT + (size_t)rm(c0 + 4 * ng + j) * K + k0 + 16 * c) = (u32x4){out[j][0], out[j][1], out[j][2], out[j][3]};
    LDS_WAIT(); asm volatile("" ::: "memory");
}
template <bool Q8, class RowMap>
__device__ __forceinline__ void transpose_item(const float* W, int ldw, int k0, int c0, void* WT, int K, const RowMap& rm, const float* kscale, float mul, LAS float* scr, int lane) {
    f32x4 v[16]; titem_load(v, W, ldw, k0, c0, lane); titem_store<Q8>(v, k0, c0, WT, K, rm, kscale, mul, scr, lane);
}
struct RowId { __device__ __forceinline__ int operator()(int n) const { return n; } };
struct RowGU { __device__ __forceinline__ int operator()(int n) const { const int lin = n >= DFF, f = lin ? n - DFF : n; return (f >> 7) * 256 + lin * 128 + (f & 127); } };

__device__ __forceinline__ void norm_row_f16(const float* xrow, const float* gain, f16* orow, int lane, float (&xn)[32]) {
    float s = 0.f;
#pragma unroll
    for (int j = 0; j < 4; ++j) { const f32x4 a = *(const f32x4*)(xrow + 8 * (lane + 64 * j)), b = *(const f32x4*)(xrow + 8 * (lane + 64 * j) + 4);
#pragma unroll
        for (int i = 0; i < 4; ++i) { xn[8 * j + i] = a[i]; xn[8 * j + 4 + i] = b[i]; s += a[i] * a[i] + b[i] * b[i]; } }
    const float rs = 1.0f / sqrtf(wave_sum(s) * (1.0f / DM) + EPS);
#pragma unroll
    for (int j = 0; j < 4; ++j) { const f32x4 ga = *(const f32x4*)(gain + 8 * (lane + 64 * j)), gb = *(const f32x4*)(gain + 8 * (lane + 64 * j) + 4);
#pragma unroll
        for (int i = 0; i < 4; ++i) { xn[8 * j + i] *= rs * ga[i]; xn[8 * j + 4 + i] *= rs * gb[i]; }
        *(f16x8*)(orow + 8 * (lane + 64 * j)) = pack8h((f32x4){xn[8 * j], xn[8 * j + 1], xn[8 * j + 2], xn[8 * j + 3]}, (f32x4){xn[8 * j + 4], xn[8 * j + 5], xn[8 * j + 6], xn[8 * j + 7]}); }
}

__device__ __forceinline__ void ssm_tables(int g, int part, const float* lam_re, const float* lam_im, const float* log_step, const float* b_re, const float* b_im, const float* c_re, const float* c_im,
                                           const float* d_skip, f16* KT, f16* MIN, f16* MOUT, float* L64, LAS unsigned char* lds, int tid) {
    constexpr int PWS = 65, CBS = 80;
    LAS f32x2* Pw = (LAS f32x2*)lds;
    LAS f32x2* Bb = Pw + 65 * PWS;
    LAS f32x2* Cc = Bb + 64 * 16;
    LAS f32x2* Cf = Cc + 16 * 64;
    LAS float* CB = (LAS float*)(Cf + 64);
    const double dt = exp((double)log_step[g]);
    if (tid < 64) { const int p = tid; const double lr = lam_re[g * 64 + p], li = lam_im[g * 64 + p];
        const double mag = exp(lr * dt), br = mag * cos(li * dt), bi = mag * sin(li * dt);
        double pr = 1.0, pi = 0.0;
        for (int j = 0; j <= 64; ++j) { Pw[j * PWS + p] = (f32x2){(float)pr, (float)pi}; const double nr = pr * br - pi * bi, ni = pr * bi + pi * br; pr = nr; pi = ni; }
        const double nr = br - 1.0, ni = bi, den = lr * lr + li * li;
        Cf[p] = (f32x2){(float)((nr * lr + ni * li) / den), (float)((ni * lr - nr * li) / den)}; }
    __syncthreads();
    for (int i = tid; i < 64 * 16; i += 512) { const int p = i >> 4; const f32x2 cf = Cf[p];
        const float br = b_re[(size_t)g * 1024 + i], bi = b_im[(size_t)g * 1024 + i];
        Bb[i] = (f32x2){cf[0] * br - cf[1] * bi, cf[0] * bi + cf[1] * br}; }
    for (int i = tid; i < 16 * 64; i += 512) Cc[i] = (f32x2){c_re[(size_t)g * 1024 + i], c_im[(size_t)g * 1024 + i]};
    __syncthreads();
    f16* KTg = KT + (size_t)g * (65 * 256);
    for (int i = tid; i < 64 * 64; i += 512) { const int p = i >> 6, c = i & 63, cg = 64 * part + c; const f32x2 B = Bb[p * 16 + (cg & 15)], C = Cc[(cg >> 4) * 64 + p];
        CB[(2 * p) * CBS + c] = C[0] * B[0] - C[1] * B[1]; CB[(2 * p + 1) * CBS + c] = -(C[0] * B[1] + C[1] * B[0]); }
    if (tid < 64) KTg[64 * part + tid] = (f16)0.f;
    __syncthreads();
    { const int lane = tid & 63, wv = tid >> 6, l16 = lane & 15, kq = lane >> 4; const LAS float* Pf = (const LAS float*)Pw;
#pragma unroll
      for (int q = 0; q < 2; ++q) { const int mt = (2 * wv + q) >> 2, nt = (2 * wv + q) & 3; f32x4 acc = {0.f, 0.f, 0.f, 0.f};
          const LAS float* ap = Pf + (16 * mt + l16) * (2 * PWS) + kq; const LAS float* bp = CB + kq * CBS + 16 * nt + l16;
#pragma unroll 8
          for (int ks = 0; ks < 32; ++ks) acc = __builtin_amdgcn_mfma_f32_16x16x4f32(ap[4 * ks], bp[4 * ks * CBS], acc, 0, 0, 0);
          const int cg = 64 * part + 16 * nt + l16;
#pragma unroll
          for (int r = 0; r < 4; ++r) { const int j = 16 * mt + 4 * kq + r; float v = acc[r];
              if (j == 0 && (cg >> 4) == (cg & 15)) v += d_skip[g * 16 + (cg >> 4)];
              KTg[(j + 1) * 256 + cg] = (f16)v; } } }
    f16* MINg = MIN + (size_t)g * (128 * 1024);
    for (int v = part * 4096 + tid; v < (part + 1) * 4096; v += 512) { const int row = v >> 7, cv = v & 127, ri = row >> 6, p = row & 63, s_ = cv >> 1, h0 = (cv & 1) * 8;
        const f32x2 P = Pw[(63 - s_) * PWS + p]; float o[8];
#pragma unroll
        for (int q = 0; q < 8; ++q) { const f32x2 B = Bb[p * 16 + h0 + q]; o[q] = ri == 0 ? P[0] * B[0] - P[1] * B[1] : P[0] * B[1] + P[1] * B[0]; }
        *(f16x8*)(MINg + (size_t)row * 1024 + cv * 8) = pack8h((f32x4){o[0], o[1], o[2], o[3]}, (f32x4){o[4], o[5], o[6], o[7]}); }
    f16* MOUTg = MOUT + (size_t)g * (1024 * 128);
    for (int v = part * 4096 + tid; v < (part + 1) * 4096; v += 512) { const int row = v >> 4, cv = v & 15, t = row >> 4, ho = row & 15, ri = cv >> 3, p0 = (cv & 7) * 8; float o[8];
#pragma unroll
        for (int q = 0; q < 8; ++q) { const f32x2 P = Pw[(t + 1) * PWS + p0 + q], C = Cc[ho * 64 + p0 + q]; o[q] = ri == 0 ? C[0] * P[0] - C[1] * P[1] : -(C[0] * P[1] + C[1] * P[0]); }
        *(f16x8*)(MOUTg + (size_t)row * 128 + cv * 8) = pack8h((f32x4){o[0], o[1], o[2], o[3]}, (f32x4){o[4], o[5], o[6], o[7]}); }
    if (part == 0 && tid < 64) *(f32x2*)(L64 + (size_t)(g * 64 + tid) * 2) = Pw[64 * PWS + tid];
    __syncthreads();
}

__device__ __forceinline__ void cumsum_unit(int bh, const float* FL, float* CNEG, LAS unsigned char* lds, int tid) {
    const int b = bh >> 3, h = bh & 7; LAS float* tot = (LAS float*)lds;
    float v[16]; float run = 0.f;
#pragma unroll
    for (int i = 0; i < 16; ++i) { const float x = FL[((size_t)b * SEQ + 16 * tid + i) * 8 + h];
        const float ls = fminf(x, 0.f) - log1pf(__expf(-fabsf(x))); run += ls; v[i] = run; }
    tot[tid] = run; __syncthreads();
    for (int off = 1; off < 512; off <<= 1) { const float a = tid >= off ? tot[tid - off] : 0.f; __syncthreads(); tot[tid] += a; __syncthreads(); }
    const float base = tid > 0 ? tot[tid - 1] : 0.f;
#pragma unroll
    for (int i = 0; i < 16; ++i) CNEG[(size_t)bh * SEQ + 16 * tid + i] = -(base + v[i]) * 11.313708498984761f;
    __syncthreads();
}

struct RouteRec { int e, slot; float gate; int pad; };
__device__ __forceinline__ void router_task(int task, int half, LAS float* pl, const f16* H2, const float* ss_h2, const float* g_moe, const f16* WR, const float* b_router,
                                            unsigned char* X2N, RouteRec* ROUTE, int* ROWTOK, unsigned* cnt, LAS float* lg, int lane, bool commit = true) {
    const int n16 = lane & 15, kq = lane >> 4, tok = task * 16 + n16;
    const float rs = 1.0f / sqrtf(epi::ss_quad<32>(ss_h2 + (size_t)tok * 32, kq) * (1.0f / DM) + EPS);
    f32x4 acc0 = {0.f, 0.f, 0.f, 0.f}, acc1 = {0.f, 0.f, 0.f, 0.f};
    const f16* hrow = H2 + (size_t)tok * DM + 8 * kq; unsigned char* xrow = X2N + (size_t)tok * DM + 8 * kq;
    const f16* w0 = WR + (size_t)n16 * DM + 8 * kq; const f16* w1 = w0 + (size_t)16 * DM;
#pragma unroll 8
    for (int ks = 32 * half; ks < 32 * half + 32; ++ks) {
        const f16x8 hv = *(const f16x8*)(hrow + ks * 32);
        const f32x4 a = {(float)hv[0], (float)hv[1], (float)hv[2], (float)hv[3]}, b = {(float)hv[4], (float)hv[5], (float)hv[6], (float)hv[7]};
        const f32x4 ga = *(const f32x4*)(g_moe + ks * 32 + 8 * kq), gb = *(const f32x4*)(g_moe + ks * 32 + 8 * kq + 4);
        const f32x4 xa = a * ga * rs, xb = b * gb * rs;
        const f16x8 xh = pack8h(xa, xb);
        *(u32x2*)(xrow + ks * 32) = pack8q(xa, xb);
        const f16x8 b0 = *(const f16x8*)(w0 + ks * 32), b1 = *(const f16x8*)(w1 + ks * 32);
        acc0 = __builtin_amdgcn_mfma_f32_16x16x32_f16(xh, b0, acc0, 0, 0, 0);
        acc1 = __builtin_amdgcn_mfma_f32_16x16x32_f16(xh, b1, acc1, 0, 0, 0);
    }
    if (half == 1) { *(LAS f32x4*)(pl + lane * 8) = acc0; *(LAS f32x4*)(pl + lane * 8 + 4) = acc1; }
    __syncthreads();
    if (half == 0) { acc0 = acc0 + *(const LAS f32x4*)(pl + lane * 8); acc1 = acc1 + *(const LAS f32x4*)(pl + lane * 8 + 4);
#pragma unroll
        for (int r = 0; r < 4; ++r) { lg[(4 * kq + r) * 33 + n16] = acc0[r]; lg[(4 * kq + r) * 33 + 16 + n16] = acc1[r]; } }
    LDS_WAIT(); asm volatile("" ::: "memory");
    if (lane < 16 && commit && half == 0) {
        float v[NE];
#pragma unroll
        for (int e = 0; e < NE; ++e) v[e] = lg[lane * 33 + e] + b_router[e];
        float tv[TOPK]; int te[TOPK];
#pragma unroll
        for (int j = 0; j < TOPK; ++j) { float best = -__builtin_inff(); int bi = 0;
#pragma unroll
            for (int e = 0; e < NE; ++e) { const bool gt = v[e] > best; best = gt ? v[e] : best; bi = gt ? e : bi; }
            tv[j] = best; te[j] = bi;
#pragma unroll
            for (int e = 0; e < NE; ++e) v[e] = (e == bi) ? -__builtin_inff() : v[e]; }
        float ex[TOPK], sum = 0.f;
#pragma unroll
        for (int j = 0; j < TOPK; ++j) { ex[j] = __expf(tv[j] - tv[0]); sum += ex[j]; }
        const float inv = 1.0f / sum; const int t = task * 16 + lane;
#pragma unroll
        for (int j = 0; j < TOPK; ++j) { const int slot = (int)atomicAdd(cnt + te[j] * CNT_STRIDE, 1u);
            ROWTOK[(size_t)te[j] * M + slot] = t;
            RouteRec rr; rr.e = te[j]; rr.slot = slot; rr.gate = ex[j] * inv; rr.pad = 0; ROUTE[(size_t)t * TOPK + j] = rr; }
    }
    LDS_WAIT(); asm volatile("" ::: "memory");
}

__device__ __forceinline__ void moe_table(const unsigned* cnt, LAS int* tab, int tid) {
    __syncthreads();
    if (tid == 0) { int run = 0;
        for (int e = 0; e < NE; ++e) { const int c = (int)cnt[e * CNT_STRIDE]; tab[e] = run; tab[64 + e] = c; run += (c + 255) >> 8; }
        tab[32] = run; }
    __syncthreads();
}

__device__ __forceinline__ void final_row(int tok, const f16* H2, const unsigned char* YS, const RouteRec* ROUTE, const LAS int* tab, const float* g_final, float* out, int lane) {
    float v[32];
#pragma unroll
    for (int j = 0; j < 4; ++j) { const f16x8 hv = *(const f16x8*)(H2 + (size_t)tok * DM + 8 * (lane + 64 * j));
#pragma unroll
        for (int i = 0; i < 8; ++i) v[8 * j + i] = (float)hv[i]; }
#pragma unroll
    for (int q = 0; q < TOPK; ++q) { const RouteRec rr = ROUTE[(size_t)tok * TOPK + q]; const size_t row = (size_t)tab[rr.e] * 256 + rr.slot;
#pragma unroll
        for (int j = 0; j < 4; ++j) { const u32x2 y = *(const u32x2*)(YS + row * DM + 8 * (lane + 64 * j));
            const f32x2 y0 = __builtin_amdgcn_cvt_pk_f32_fp8(y[0], false), y1 = __builtin_amdgcn_cvt_pk_f32_fp8(y[0], true), y2 = __builtin_amdgcn_cvt_pk_f32_fp8(y[1], false), y3 = __builtin_amdgcn_cvt_pk_f32_fp8(y[1], true);
            v[8 * j + 0] += rr.gate * y0[0]; v[8 * j + 1] += rr.gate * y0[1]; v[8 * j + 2] += rr.gate * y1[0]; v[8 * j + 3] += rr.gate * y1[1];
            v[8 * j + 4] += rr.gate * y2[0]; v[8 * j + 5] += rr.gate * y2[1]; v[8 * j + 6] += rr.gate * y3[0]; v[8 * j + 7] += rr.gate * y3[1]; } }
    float s = 0.f;
#pragma unroll
    for (int i = 0; i < 32; ++i) s += v[i] * v[i];
    const float rs = 1.0f / sqrtf(wave_sum(s) * (1.0f / DM) + EPS);
#pragma unroll
    for (int j = 0; j < 4; ++j) { const f32x4 ga = *(const f32x4*)(g_final + 8 * (lane + 64 * j)), gb = *(const f32x4*)(g_final + 8 * (lane + 64 * j) + 4);
        f32x4 oa, ob;
#pragma unroll
        for (int i = 0; i < 4; ++i) { oa[i] = v[8 * j + i] * rs * ga[i]; ob[i] = v[8 * j + 4 + i] * rs * gb[i]; }
        *(f32x4*)(out + (size_t)tok * DM + 8 * (lane + 64 * j)) = oa; *(f32x4*)(out + (size_t)tok * DM + 8 * (lane + 64 * j) + 4) = ob; }
}

#ifndef MK_N_LAUNCHES
#define MK_N_LAUNCHES 1
#endif
constexpr int N_PHASES = 12;
struct Args { const float* in[31]; float* out; unsigned char* ws; int ph_lo, ph_hi, li, pad; };
static_assert(sizeof(Args) == 280 && __builtin_offsetof(Args, out) == 248 && __builtin_offsetof(Args, ws) == 256, "kernarg layout used by INP/OUTP/PHASE_WS");
enum { I_X = 0, I_MEM, I_GMIX, I_WIN, I_BF, I_LRE, I_LIM, I_LSTEP, I_BRE, I_BIM, I_CRE, I_CIM, I_DSKIP, I_WGLU, I_BGLU, I_GATT, I_GSSM, I_WOUT, I_GCROSS, I_GMEM,
       I_WCQ, I_WCKV, I_WCO, I_GMOE, I_WR, I_BR, I_WGU, I_BGU, I_WDN, I_BDN, I_GFINAL };

__global__ void __launch_bounds__(NWAVES * 64, 2) fwd(Args args) {
    extern __shared__ __attribute__((aligned(16))) unsigned char lds_raw[];
    LAS unsigned char* const lds = (LAS unsigned char*)lds_raw;
    const int G = gridDim.x, bx = blockIdx.x, vcu = (G % 8 == 0) ? (bx % 8) * (G / 8) + bx / 8 : bx;
    { const int t0 = threadIdx.x; for (int u = t0; u < (LDS_BYTES - MISC_OFF) / 4; u += NWAVES * 64) ((LAS unsigned*)(lds + MISC_OFF))[u] = 0u; }
    __syncthreads();
#ifndef PHASE_MASK
#define PHASE_MASK 0xFFF
#endif
    const int lo = args.ph_lo, hi = args.ph_hi;
    const bool IN2_ = ((PHASE_MASK >> 2) & 1) && lo <= 2 && 2 < hi;
    XcdBarrier bar; bar.bar = (unsigned*)(args.ws + WS_CTL) + CW_BAR + args.li * XCD_BAR_WORDS; bar.x = 0; bar.st = nullptr; bar.gexp = 0u;
    if (hi - lo > 1) bar = xcd_barrier_post((unsigned*)(args.ws + WS_CTL) + CW_BAR + args.li * XCD_BAR_WORDS, (volatile LAS unsigned*)(lds + MISC_OFF));
    const bool fuse23 = IN2_ && (G % 16 == 0);
    XcdBarrier bar2 = bar;
    if (fuse23 && (vcu & 1) == 0) bar2 = xcd_barrier_post((unsigned*)(args.ws + WS_CTL) + CW_BAR + 3 * XCD_BAR_WORDS, (volatile LAS unsigned*)(lds + MISC_OFF + 8), (unsigned)(G / 2));
#define IN(k) (((PHASE_MASK >> (k)) & 1) && lo <= (k) && (k) < hi)
#define SEAM(k) do { if (IN(k) && IN((k) + 1)) xcd_barrier(bar); } while (0)
#define SEAM2(k, k2) do { if (IN(k) && IN(k2)) xcd_barrier(bar); } while (0)
#ifndef REPEAT_PHASE
#define REPEAT_PHASE -1
#endif
#define REP(k) for (int rep_ = 0; rep_ < ((k) == REPEAT_PHASE ? 2 : 1); (void)(++rep_), __syncthreads())
#define WSP(T, off) ((T*)(wsb + (off)))
typedef const unsigned char __attribute__((address_space(4)))* kaptr_t;
#define PHASE_WS() kaptr_t kab = (kaptr_t)__builtin_amdgcn_kernarg_segment_ptr(); asm volatile("" : "+s"(kab)); \
        GAS unsigned char* wsg_ = *(GAS unsigned char* const __attribute__((address_space(4)))*)(kab + 256); asm volatile("" : "+s"(wsg_)); unsigned char* wsb = (unsigned char*)wsg_
#define INP(i) ((const float*)*(GAS const float* const __attribute__((address_space(4)))*)(kab + 8 * (i)))
#define OUTP() ((float*)*(GAS float* const __attribute__((address_space(4)))*)(kab + 248))
#define SUB_WS() do { asm volatile("" : "+s"(wsg_)); wsb = (unsigned char*)wsg_; } while (0)
#define TIDS() const int tid = opaque_tid(), lane = tid & 63, wave = __builtin_amdgcn_readfirstlane(tid >> 6), gw = vcu * NWAVES + wave, NGW = G * NWAVES; (void)lane; (void)gw; (void)NGW

    REP(0) if (IN(0)) { PHASE_WS();
#ifndef P0A_REP
#define P0A_REP 1
#endif
#ifndef P0B_REP
#define P0B_REP 1
#endif
        for (int r4 = 0; r4 < P0A_REP; ++r4)
        { TIDS();
          ssm_tables(vcu >> 2, vcu & 3, INP(I_LRE), INP(I_LIM), INP(I_LSTEP), INP(I_BRE), INP(I_BIM), INP(I_CRE), INP(I_CIM), INP(I_DSKIP),
                                   WSP(f16, WS_KT), WSP(f16, WS_MIN), WSP(f16, WS_MOUT), WSP(float, WS_L64), lds, tid); }
        for (int r4 = 0; r4 < P0B_REP; ++r4)
        {
            TIDS();
            LAS float* wf = (LAS float*)lds; const float* w_in = INP(I_WIN);
            for (int i = tid; i < DM * 8; i += NWAVES * 64) wf[i + (i >> 6) * 4] = w_in[(size_t)(i >> 3) * INC + 4 * AW + (i & 7)];
            __syncthreads();
            f16* XN = WSP(f16, WS_XN); float* FL = WSP(float, WS_FL);
            {   f32x4 nx[8]; const float* xin = INP(I_X);
#pragma unroll
                for (int j = 0; j < 4; ++j) { nx[2 * j] = *(const f32x4*)(xin + (size_t)gw * DM + 8 * (lane + 64 * j)); nx[2 * j + 1] = *(const f32x4*)(xin + (size_t)gw * DM + 8 * (lane + 64 * j) + 4); }
#pragma unroll 1
                for (int m = gw; m < M; m += NGW) {
                    f32x4 cx[8];
#pragma unroll
                    for (int q = 0; q < 8; ++q) cx[q] = nx[q];
                    const int mn = (m + NGW < M) ? m + NGW : m;
#pragma unroll
                    for (int j = 0; j < 4; ++j) { nx[2 * j] = *(const f32x4*)(xin + (size_t)mn * DM + 8 * (lane + 64 * j)); nx[2 * j + 1] = *(const f32x4*)(xin + (size_t)mn * DM + 8 * (lane + 64 * j) + 4); }
                    float sq = 0.f;
#pragma unroll
                    for (int j = 0; j < 4; ++j)
#pragma unroll
                        for (int i = 0; i < 4; ++i) sq += cx[2 * j][i] * cx[2 * j][i] + cx[2 * j + 1][i] * cx[2 * j + 1][i];
                    const float rs = 1.0f / sqrtf(wave_sum(sq) * (1.0f / DM) + EPS);
#pragma unroll
                    for (int j = 0; j < 4; ++j) { const f32x4 ga = *(const f32x4*)(INP(I_GMIX) + 8 * (lane + 64 * j)), gb = *(const f32x4*)(INP(I_GMIX) + 8 * (lane + 64 * j) + 4);
                        cx[2 * j] = cx[2 * j] * (ga * rs); cx[2 * j + 1] = cx[2 * j + 1] * (gb * rs);
                        *(f16x8*)(XN + (size_t)m * DM + 8 * (lane + 64 * j)) = pack8h(cx[2 * j], cx[2 * j + 1]); }
                    float fl[8] = {0.f, 0.f, 0.f, 0.f, 0.f, 0.f, 0.f, 0.f};
#pragma unroll
                    for (int j = 0; j < 4; ++j) {
#pragma unroll
                        for (int i = 0; i < 8; ++i) { const int k = 8 * (lane + 64 * j) + i; const f32x4 wa = *(const LAS f32x4*)(wf + k * 8 + (lane + 64 * j) * 4), wb = *(const LAS f32x4*)(wf + k * 8 + (lane + 64 * j) * 4 + 4);
                            const float xv = cx[2 * j + (i >> 2)][i & 3];
#pragma unroll
                            for (int h = 0; h < 4; ++h) { fl[h] += xv * wa[h]; fl[4 + h] += xv * wb[h]; } }
                        __builtin_amdgcn_sched_barrier(0); }
#pragma unroll
                    for (int h = 0; h < 8; ++h) fl[h] = wave_sum(fl[h]);
                    if (lane < 8) { float v = fl[0];
#pragma unroll
                        for (int h = 1; h < 8; ++h) v = (lane == h) ? fl[h] : v;
                        FL[(size_t)m * 8 + lane] = v + INP(I_BF)[lane]; }
                }
            }
            f16* MEMN = WSP(f16, WS_MEMN);
            for (int m = gw; m < BATCH * MEML; m += NGW) { float xn[32]; norm_row_f16(INP(I_MEM) + (size_t)m * DM, INP(I_GMEM), MEMN + (size_t)m * DM, lane, xn); }
            {
                const float* wq = INP(I_WCQ); const float* gc = INP(I_GCROSS); f16* WCQS = WSP(f16, WS_WCQ);
                for (int v = gw * 64 + lane; v < DM * DM / 8; v += NGW * 64) { const float sc = gc[v >> 8] * 0.04419417382415922f;
                    const f32x4 a = *(const f32x4*)(wq + (size_t)v * 8), b = *(const f32x4*)(wq + (size_t)v * 8 + 4);
                    *(f16x8*)(WCQS + (size_t)v * 8) = pack8h(a * sc, b * sc); } }
            f16* WRT = WSP(f16, WS_WR);
            for (int i = gw * 64 + lane; i < NE * DM; i += NGW * 64) { const int e = i / DM, k = i % DM; WRT[i] = (f16)INP(I_WR)[(size_t)k * NE + e]; }
            __syncthreads();
        }
        {
            TIDS();
            LAS float* scr = (LAS float*)(lds + wave * (64 * 65 * 4));
            constexpr int I_IN = 32 * 64, I_GL = 16 * 16, I_OU = 32 * 32, I_KV = 32 * 64, I_CO = 32 * 32;
            constexpr int NITEMS = I_IN + I_GL + I_OU + I_KV + I_CO;
            const RowId rid;
            for (int it = gw; it < NITEMS; it += NGW) {
                int r = it;
                if (r < I_IN) { transpose_item<false>(INP(I_WIN), INC, 64 * (r / 64), 64 * (r % 64), WSP(f16, WS_WIN), DM, rid, nullptr, 1.0f, scr, lane); continue; } r -= I_IN;
                if (r < I_GL) { transpose_item<false>(INP(I_WGLU), SSMW, 64 * (r / 16), 64 * (r % 16), WSP(f16, WS_WGLU), SSMW, rid, nullptr, 1.0f, scr, lane); continue; } r -= I_GL;
                if (r < I_OU) { const int kb = r / 32; const float* ksc = kb < 16 ? INP(I_GATT) : INP(I_GSSM) - AW;
                    transpose_item<false>(INP(I_WOUT), DM, 64 * kb, 64 * (r % 32), WSP(f16, WS_WOUT), DM, rid, ksc, 1.0f, scr, lane); continue; } r -= I_OU;
                if (r < I_KV) { transpose_item<false>(INP(I_WCKV), 2 * DM, 64 * (r / 64), 64 * (r % 64), WSP(f16, WS_WCKV), DM, rid, nullptr, 1.0f, scr, lane); continue; } r -= I_KV;
                transpose_item<false>(INP(I_WCO), DM, 64 * (r / 32), 64 * (r % 32), WSP(f16, WS_WCO), DM, rid, nullptr, 1.0f, scr, lane);
            }
        }
    }
    SEAM(0);
    REP(1) if (IN(1)) { PHASE_WS();
        if (vcu < BATCH * AH) { TIDS(); cumsum_unit(vcu, WSP(float, WS_FL), WSP(float, WS_CNEG), lds, tid); }
        pg8::DenseOrder S; S.init(WSP(f16, WS_XN), WSP(f16, WS_WIN), M, 4 * AW, DM, G, bx);
        epi::InProj E{WSP(f16, WS_U), WSP(f16, WS_Q), (size_t)(WS_K - WS_Q) / 2, (int*)(wsb + WS_CTL) + CW_KMAX};
        pg8::gemm_phase<epi::InProj, pg8::DenseOrder>(lds, DM * 2, S, E);
    }
    SEAM(1);
#ifndef P2A_REP
#define P2A_REP 1
#endif
#ifndef P2B_REP
#define P2B_REP 1
#endif
    REP(2) if (IN(2)) { PHASE_WS();
        if ((vcu & 1) == 0) {
            const int w = vcu >> 1;
#pragma unroll 1
            for (int q = 0; q < 2 * P2A_REP; ++q) { const int id = 2 * w + (q & 1);
                fox::item(id >> 4, id & 15, WSP(f16, WS_Q), WSP(f16, WS_K), WSP(f16, WS_V), WSP(f16, WS_MIX), WSP(float, WS_SSATT), WSP(float, WS_CNEG), (const float*)(wsb + WS_CTL) + CW_KMAX, (char*)lds_raw); }
            SUB_WS();
#pragma unroll 1
            for (int q = 0; q < 2 * P2B_REP; ++q) { const int id = (q & 1) == 0 ? w : 255 - w;
                ssm::unit((id >> 1) >> 6, (id >> 1) & 63, id & 1, WSP(f16, WS_U), WSP(f16, WS_KT), WSP(f16, WS_MIN), WSP(f16, WS_MOUT), WSP(float, WS_L64), WSP(f16, WS_G), lds); }
            SUB_WS();
            {
                pg8::DenseOrder S; S.init(WSP(f16, WS_MEMN), WSP(f16, WS_WCKV), BATCH * MEML, 2 * DM, DM, G, (w & 7) < 2 ? 2 * (w >> 3) + (w & 7) : (1 << 20));
                epi::PlainF16 E{WSP(f16, WS_KVC), 2 * DM};
                pg8::gemm_phase<epi::PlainF16, pg8::DenseOrder>(lds, DM * 2, S, E);
            }
            if (fuse23) {
                xcd_barrier(bar2);
                SUB_WS();
                const int c2 = (bx & 7) + 8 * ((bx >> 3) >> 1);
                {   pg8::DenseOrder S; S.init(WSP(f16, WS_G), WSP(f16, WS_WGLU), M, SSMW, SSMW, G / 2, c2);
                    epi::Glu E{WSP(f16, WS_G), INP(I_BGLU), WSP(f16, WS_MIX), WSP(float, WS_SSSSM)};
                    pg8::gemm_phase<epi::Glu, pg8::DenseOrder>(lds, SSMW * 2, S, E); }
                SUB_WS();
                {   epi::CrossPreOut EP{WSP(unsigned char, WS_WKT), WSP(unsigned char, WS_VWT)};
                    pg8::CrossPre<0> S0{WSP(f16, WS_KVC), WSP(f16, WS_WCQ), c2 < 64 ? c2 : -1};
                    pg8::gemm_phase<epi::CrossPreOut, pg8::CrossPre<0>>(lds, CD * 2, S0, EP);
                    pg8::CrossPre<1> S1{WSP(f16, WS_KVC), WSP(f16, WS_WCO), (c2 >= 64 && c2 < 128) ? c2 - 64 : -1};
                    pg8::gemm_phase<epi::CrossPreOut, pg8::CrossPre<1>>(lds, CD * 2, S1, EP); }
            }
        }
        SUB_WS();
        {
            TIDS();
            LAS float* scr = (LAS float*)(lds + wave * (128 * 33 * 4));
            constexpr int I_GU = NE * 16 * 128, I_DN = NE * 16 * 64, NI = I_GU + I_DN, CH = 8;
            const RowId rid; const RowGU rgu;
#ifndef P2C_REP
#define P2C_REP 1
#endif
#pragma unroll 1
            for (int r3 = 0; r3 < P2C_REP; ++r3) {
            unsigned* claim = (unsigned*)(wsb + WS_CTL) + CW_CLAIM + 64 * r3;
#define XI_LOAD(v, it) do { int r_ = (it); if (r_ < I_GU) { const int e = r_ / 2048, q = r_ % 2048; qitem_load(v, INP(I_WGU) + (size_t)e * DM * 2 * DFF, 2 * DFF, 128 * (q / 128), 32 * (q % 128), lane); } \
        else { r_ -= I_GU; const int e = r_ / 1024, q = r_ % 1024; qitem_load(v, INP(I_WDN) + (size_t)e * DFF * DM, DM, 128 * (q / 64), 32 * (q % 64), lane); } } while (0)
#define XI_STORE(v, it) do { int r_ = (it); if (r_ < I_GU) { const int e = r_ / 2048, q = r_ % 2048; qitem_store(v, 128 * (q / 128), 32 * (q % 128), WSP(unsigned char, WS_WGU) + (size_t)e * 2 * DFF * DM, DM, rgu, WQ_SCALE, scr, lane); } \
        else { r_ -= I_GU; const int e = r_ / 1024, q = r_ % 1024; qitem_store(v, 128 * (q / 64), 32 * (q % 64), WSP(unsigned char, WS_WDN) + (size_t)e * DM * DFF, DFF, rid, WQ_SCALE, scr, lane); } } while (0)
            volatile LAS int* cw = (volatile LAS int*)(lds + MISC_OFF + 32);
#define XI_NEXT(dst, par) do { if (tid == 0) cw[par] = (int)atomicAdd(claim, 1u) * CH; __syncthreads(); dst = cw[par] + wave; } while (0)
            int ia, ib;
            f32x4 va[16], vb[16];
            XI_NEXT(ia, 0); if (ia < NI) XI_LOAD(va, ia);
            while (ia < NI) {
                XI_NEXT(ib, 1); if (ib < NI) XI_LOAD(vb, ib);
                XI_STORE(va, ia); if (ib >= NI) break;
                XI_NEXT(ia, 0); if (ia < NI) XI_LOAD(va, ia);
                XI_STORE(vb, ib);
            }
            __syncthreads();
            }
#undef XI_LOAD
#undef XI_STORE
#undef XI_NEXT
        }
    }
    SEAM2(2, 4);
#ifndef EXTRA_BARS
#define EXTRA_BARS 0
#endif
    if (hi - lo > 1) for (int xb_ = 0; xb_ < EXTRA_BARS; ++xb_) xcd_barrier(bar);
    REP(4) if (IN(4)) { PHASE_WS();
        pg8::DenseOrder S; S.init(WSP(f16, WS_MIX), WSP(f16, WS_WOUT), M, DM, DM, G, bx);
        epi::OutProj E{INP(I_X), WSP(f16, WS_HA), WSP(float, WS_SSATT), WSP(float, WS_SSSSM), WSP(float, WS_SSH), WSP(unsigned char, WS_H8)};
        pg8::gemm_phase<epi::OutProj, pg8::DenseOrder, true>(lds, DM * 2, S, E, (LAS float*)(lds + MSC_OFF));
    }
    SEAM(4);
    REP(5) if (IN(5)) { PHASE_WS();
        pg8::DenseOrder S; S.init(WSP(f16, WS_H8), WSP(f16, WS_WKT), M, CH * MEML, DM / 2, G, bx, (size_t)CH * MEML * DM);
        epi::CrossSoftmax E{WSP(unsigned char, WS_PB), WSP(float, WS_SSH), (LAS float*)(lds + XCH_OFF)};
        pg8::gemm_phase<epi::CrossSoftmax, pg8::DenseOrder, false, true>(lds, DM, S, E);
    }
    SEAM(5);
    REP(7) if (IN(7)) { PHASE_WS();
        pg8::DenseOrder S; S.init(WSP(f16, WS_PB), WSP(f16, WS_VWT), M, DM, CH * MEML / 2, G, bx, (size_t)DM * CH * MEML);
        epi::CrossO E{WSP(f16, WS_HA), WSP(float, WS_SSH2)};
        pg8::gemm_phase<epi::CrossO, pg8::DenseOrder, false, true>(lds, CH * MEML, S, E);
    }
    SEAM(7);
    REP(8) if (IN(8)) { PHASE_WS();
        TIDS();
        LAS float* lg = (LAS float*)(lds + wave * (16 * 33 * 4));
#ifndef P8_REP
#define P8_REP 1
#endif
        for (int r5 = 0; r5 < P8_REP; ++r5)
        { const int t = (wave & 3) * G + vcu;
          router_task(t < M / 16 ? t : 0, wave >> 2, (LAS float*)(lds + NWAVES * 16 * 33 * 4) + (wave & 3) * 512, WSP(f16, WS_HA), WSP(float, WS_SSH2), INP(I_GMOE), WSP(f16, WS_WR), INP(I_BR), WSP(unsigned char, WS_X2N), WSP(RouteRec, WS_ROUTE), WSP(int, WS_ROWTOK),
                                                           (unsigned*)(wsb + WS_CTL) + CW_CNT, lg, lane, r5 == P8_REP - 1 && t < M / 16); }
    }
    SEAM(8);
    REP(9) if (IN(9)) { PHASE_WS();
        { TIDS(); moe_table((unsigned*)(wsb + WS_CTL) + CW_CNT, (LAS int*)(lds + MOE_TAB_OFF), tid); }
        MoeOrder<true> S{(LAS int*)(lds + MOE_TAB_OFF), (const char*)WSP(char, WS_X2N), (const char*)WSP(char, WS_WGU), WSP(int, WS_ROWTOK), (size_t)2 * DFF * DM, DM, 16, G, bx};
        epi::ExpertGU E{WSP(unsigned char, WS_ACT), INP(I_BGU)};
        pg8::gemm_phase<epi::ExpertGU, MoeOrder<true>, false, true>(lds, DM, S, E);
    }
    SEAM(9);
    REP(10) if (IN(10)) { PHASE_WS();
        { TIDS(); moe_table((unsigned*)(wsb + WS_CTL) + CW_CNT, (LAS int*)(lds + MOE_TAB_OFF), tid); }
        MoeOrder<false> S{(LAS int*)(lds + MOE_TAB_OFF), (const char*)WSP(char, WS_ACT), (const char*)WSP(char, WS_WDN), WSP(int, WS_ROWTOK), (size_t)DM * DFF, DFF, 8, G, bx};
        epi::ExpertDown E{WSP(unsigned char, WS_YS), INP(I_BDN)};
        pg8::gemm_phase<epi::ExpertDown, MoeOrder<false>, false, true>(lds, DFF, S, E);
    }
    SEAM(10);
    REP(11) if (IN(11)) { PHASE_WS();
        TIDS();
        moe_table((unsigned*)(wsb + WS_CTL) + CW_CNT, (LAS int*)(lds + MOE_TAB_OFF), tid);
        for (int m = gw; m < M; m += NGW) final_row(m, WSP(f16, WS_HA), WSP(unsigned char, WS_YS), WSP(RouteRec, WS_ROUTE), (const LAS int*)(lds + MOE_TAB_OFF), INP(I_GFINAL), OUTP(), lane);
    }
#undef IN
#undef SEAM
#undef REP
#undef WSP
#undef INP
#undef OUTP
#undef PHASE_WS
#undef SUB_WS
#undef TIDS
}

extern "C" void kernel_launch(void* const* d_in, const int* in_sizes, int n_in, void* d_out, int out_size, void* d_ws, size_t ws_size, hipStream_t stream) {
    static int grid = 0;
    if (grid == 0) {
        if (n_in != 31 || in_sizes[0] != M * DM || out_size != M * DM || ws_size < WS_END) {
            fprintf(stderr, "kernel_launch: built for 31 inputs, x/out of %d floats, >= %zu bytes of workspace; got n_in %d, in0 %d, out %d, ws %zu; nothing launched\n", M * DM, (size_t)WS_END, n_in, n_in > 0 ? in_sizes[0] : -1, out_size, ws_size);
            grid = -1; return; }
        int dev = 0, cus = 0, per_cu = 0;
        if (hipGetDevice(&dev) != hipSuccess || hipDeviceGetAttribute(&cus, hipDeviceAttributeMultiprocessorCount, dev) != hipSuccess) { fprintf(stderr, "kernel_launch: device query failed\n"); grid = -1; return; }
        if (hipFuncSetAttribute((const void*)fwd, hipFuncAttributeMaxDynamicSharedMemorySize, LDS_BYTES) != hipSuccess) { fprintf(stderr, "kernel_launch: hipFuncSetAttribute failed\n"); grid = -1; return; }
        if (hipOccupancyMaxActiveBlocksPerMultiprocessor(&per_cu, (const void*)fwd, NWAVES * 64, LDS_BYTES) != hipSuccess || per_cu < 1)
            fprintf(stderr, "kernel_launch: note: occupancy query reports %d workgroups per CU\n", per_cu);
        (void)hipGetLastError();
        grid = (cus / 16) * 16;
        if (grid != 256) fprintf(stderr, "kernel_launch: %d CUs; the phase program assumes 256\n", grid);
    }
    if (grid < 0) return;
    if (hipMemsetAsync((char*)d_ws + WS_CTL, 0, CTL_ZERO_BYTES, stream) != hipSuccess) { fprintf(stderr, "kernel_launch: memset failed\n"); return; }
    Args a{};
    for (int i = 0; i < 31; ++i) a.in[i] = (const float*)d_in[i];
    a.out = (float*)d_out; a.ws = (unsigned char*)d_ws;
    constexpr int NL = MK_N_LAUNCHES;
    for (int li = 0; li < NL; ++li) {
        a.ph_lo = (NL == 1) ? 0 : li; a.ph_hi = (NL == 1) ? N_PHASES : li + 1; a.li = 0; a.pad = 0;
        hipLaunchKernelGGL(fwd, dim3(grid), dim3(NWAVES * 64), LDS_BYTES, stream, a);
        const hipError_t le = hipPeekAtLastError();
        if (le != hipSuccess) { fprintf(stderr, "kernel_launch: launch %d failed: %s\n", li, hipGetErrorName(le)); break; }
    }
}
```

```cpp
#include <hip/hip_runtime.h>
#include <cstdio>
#include <cstdint>

#define GAS __attribute__((address_space(1)))
#define LAS __attribute__((address_space(3)))
typedef _Float16 f16;
typedef _Float16 f16x2 __attribute__((ext_vector_type(2)));
typedef _Float16 f16x4 __attribute__((ext_vector_type(4)));
typedef _Float16 f16x8 __attribute__((ext_vector_type(8)));
typedef float f32x2 __attribute__((ext_vector_type(2)));
typedef float f32x4 __attribute__((ext_vector_type(4)));
typedef float f32x16 __attribute__((ext_vector_type(16)));
typedef unsigned u32x2 __attribute__((ext_vector_type(2)));
typedef unsigned u32x4 __attribute__((ext_vector_type(4)));
typedef GAS unsigned gu32;
#define RLX_AGENT __ATOMIC_RELAXED, __HIP_MEMORY_SCOPE_AGENT
#define LDS_WAIT() asm volatile("s_waitcnt lgkmcnt(0)" ::: "memory")
#define VM_WAIT() asm volatile("s_waitcnt vmcnt(0)" ::: "memory")

constexpr int BATCH = 2, SEQ = 8192, DM = 2048, M = BATCH * SEQ;
constexpr int SSMW = 1024, SG = 16, NG = 64, SP = 64;
constexpr int AW = 1024, AH = 8, AD = 128;
constexpr int INC = SSMW + 3 * AW + AH;
constexpr int MEML = 256, CH = 4, CD = 512;
constexpr int NE = 32, TOPK = 4, DFF = 2048;
constexpr float EPS = 1e-5f;
constexpr int CT = 64, NCH = SEQ / CT;

__device__ __forceinline__ unsigned pk2h(float lo, float hi) { f32x2 v = {lo, hi}; f16x2 h = __builtin_convertvector(v, f16x2); return __builtin_bit_cast(unsigned, h); }
__device__ __forceinline__ u32x2 pack8q(f32x4 a, f32x4 b) { unsigned w0 = 0, w1 = 0;
    w0 = __builtin_amdgcn_cvt_pk_fp8_f32(a[0], a[1], w0, false); w0 = __builtin_amdgcn_cvt_pk_fp8_f32(a[2], a[3], w0, true);
    w1 = __builtin_amdgcn_cvt_pk_fp8_f32(b[0], b[1], w1, false); w1 = __builtin_amdgcn_cvt_pk_fp8_f32(b[2], b[3], w1, true); return (u32x2){w0, w1}; }
constexpr float XH_SCALE = 16.0f, XK_SCALE = 256.0f, XP_SCALE = 256.0f, XV_SCALE = 16.0f;
constexpr float WQ_SCALE = 32.0f, WQ_INV = 1.0f / 32.0f;
__device__ __forceinline__ f16x8 pack8h(f32x4 a, f32x4 b) { u32x4 w = {pk2h(a[0], a[1]), pk2h(a[2], a[3]), pk2h(b[0], b[1]), pk2h(b[2], b[3])}; return __builtin_bit_cast(f16x8, w); }
__device__ __forceinline__ int opaque_tid() { int t = threadIdx.x; asm volatile("" : "+v"(t)); return t; }
__device__ __forceinline__ const char* uptr(const char* p) {
    const unsigned long long v = (unsigned long long)p; const unsigned lo = __builtin_amdgcn_readfirstlane((unsigned)v), hi = __builtin_amdgcn_readfirstlane((unsigned)(v >> 32));
    return (const char*)(((unsigned long long)hi << 32) | lo); }
__device__ __forceinline__ float wave_sum(float v) {
#pragma unroll
    for (int o = 1; o < 64; o <<= 1) v += __shfl_xor(v, o);
    return v;
}

#define XB_TMO      128
#define XB_XCNT(j)  (256  + 64 * (j))
#define XB_XSUB(j)  (1280 + 64 * (j))
#define XB_XGEN(j)  (2304 + 64 * (j))
#define XB_TOP      3328
#define XB_TOPGEN   3392
#define XCD_BAR_WORDS 3456
#define XB_SPIN_CAP (1u << 18)
__device__ __forceinline__ unsigned xb_ld(unsigned* p)              { return __hip_atomic_load(p, __ATOMIC_RELAXED, __HIP_MEMORY_SCOPE_AGENT); }
__device__ __forceinline__ unsigned xb_add(unsigned* p, unsigned v) { return __hip_atomic_fetch_add(p, v, __ATOMIC_RELAXED, __HIP_MEMORY_SCOPE_AGENT); }
__device__ __forceinline__ unsigned xb_xcc_id() { return (unsigned)__builtin_amdgcn_s_getreg((3 << 11) | 20) & 0xFu; }
#define XB_SPIN(cond, bar) do { unsigned _sp = 0; while (cond) { __builtin_amdgcn_s_sleep(1); \
    if ((++_sp & 255u) == 0u) { if (xb_ld(&(bar)[XB_TMO])) break; if (_sp > XB_SPIN_CAP) { atomicAdd(&(bar)[XB_TMO], 1u); break; } } } } while (0)
struct XcdBarrier { unsigned* bar; unsigned x; volatile LAS unsigned* st; unsigned gexp; };
__device__ __forceinline__ XcdBarrier xcd_barrier_post(unsigned* bar, volatile LAS unsigned* st, unsigned gexp = 0u) {
    XcdBarrier b; b.bar = bar; b.x = xb_xcc_id(); b.st = st; b.gexp = gexp;
    if (threadIdx.x == 0) (void)xb_add(&bar[XB_XCNT(b.x)], 1u);
    return b;
}
__device__ __forceinline__ void xcd_barrier_complete(unsigned* bar, unsigned x, unsigned& nloc, unsigned& nx, unsigned gexp) {
    const unsigned G = gexp ? gexp : gridDim.x * gridDim.y * gridDim.z;
    unsigned sum, cnt, mine, sp = 0u;
    for (;;) {
        sum = 0u; cnt = 0u; mine = 0u;
#pragma unroll
        for (unsigned j = 0; j < 16; ++j) { const unsigned c = xb_ld(&bar[XB_XCNT(j)]); sum += c; cnt += (c > 0u) ? 1u : 0u; mine = (j == x) ? c : mine; }
        if (sum == G) break;
        __builtin_amdgcn_s_sleep(1);
        if ((++sp & 255u) == 0u) { if (xb_ld(&bar[XB_TMO])) break; if (sp > XB_SPIN_CAP) { atomicAdd(&bar[XB_TMO], 1u); break; } }
    }
    nloc = mine > 0u ? mine : 1u; nx = cnt > 0u ? cnt : 1u;
}
__device__ __forceinline__ void xcd_barrier(const XcdBarrier& b) {
    asm volatile("s_waitcnt vmcnt(0)" ::: "memory");
    __syncthreads();
    if (threadIdx.x == 0) {
        unsigned* bar = b.bar;
        __builtin_amdgcn_s_waitcnt(0);
        unsigned nloc = b.st[0], nx = b.st[1];
        if (nloc == 0u) { xcd_barrier_complete(bar, b.x, nloc, nx, b.gexp); b.st[0] = nloc; b.st[1] = nx; }
        const unsigned old = xb_add(&bar[XB_XSUB(b.x)], 1u);
        const unsigned gen = old / nloc;
        if (old + 1u == (gen + 1u) * nloc) {
            __builtin_amdgcn_fence(__ATOMIC_RELEASE, "agent");
            asm volatile("s_waitcnt vmcnt(0)" ::: "memory");
            const unsigned og = xb_add(&bar[XB_TOP], 1u);
            const unsigned tg = og / nx;
            if (og + 1u == (tg + 1u) * nx) xb_add(&bar[XB_TOPGEN], 1u);
            else XB_SPIN(xb_ld(&bar[XB_TOPGEN]) == tg, bar);
            __builtin_amdgcn_fence(__ATOMIC_ACQUIRE, "agent");
            xb_add(&bar[XB_XGEN(b.x)], 1u);
            asm volatile("s_waitcnt vmcnt(0)" ::: "memory");
        } else {
            XB_SPIN(xb_ld(&bar[XB_XGEN(b.x)]) == gen, bar);
            __builtin_amdgcn_fence(__ATOMIC_ACQUIRE, "agent");
            asm volatile("s_waitcnt vmcnt(0)" ::: "memory");
        }
    }
    __syncthreads();
}

namespace pg8 {
constexpr int BM = 256, BK = 64, HALF = 128, HTB = HALF * BK * 2, STAGE_BYTES = 8 * HTB, NXCD = 8, WGM = 8;
__host__ __device__ __forceinline__ int lds_byte(int r, int c) { const int st = (r >> 4) * 2 + (c >> 5), rr = r & 15, cc = c & 31, ob = rr * 64 + cc * 2; return st * 1024 + (ob ^ (((ob >> 9) & 1) << 5)); }
__host__ __device__ __forceinline__ void stage_rc(int b, int& R, int& C) { const int st = b / 1024, sb = b % 1024, swz = sb ^ (((sb >> 9) & 1) << 5); R = (st >> 1) * 16 + swz / 64; C = (st & 1) * 32 + (swz % 64) / 2; }
__host__ __device__ __forceinline__ int perm32(int rho) { const int n = rho >> 4, i = rho & 15; return 8 * (i >> 2) + 4 * n + (i & 3); }

struct Unit { int pm, pn, aux; };

struct DenseOrder {
    static constexpr bool GATHER = false;
    const f16* A; const f16* Bt; int K; int nM, nN, nwg, G, c; size_t bstride;
    __device__ void init(const f16* A_, const f16* Bt_, int M_, int N_, int K_, int G_, int c_, size_t bstride_ = 0) { A = A_; Bt = Bt_; K = K_; nM = M_ / BM; nN = N_ / BM; nwg = nM * nN; G = G_; c = c_; bstride = bstride_; }
    __device__ bool next(int i, Unit& u) const {
        const long L = (long)i * G + c; if (L >= nwg) return false;
        int wgid = (int)L; { const int q = nwg / NXCD, r = nwg % NXCD, xcd = wgid % NXCD, off = wgid / NXCD; wgid = (xcd < r ? xcd * (q + 1) : r * (q + 1) + (xcd - r) * q) + off; }
        const int nig = WGM * nN, gid = wgid / nig, fm = gid * WGM, gsz = (nM - fm) < WGM ? (nM - fm) : WGM;
        u.pm = fm + ((wgid % nig) % gsz); u.pn = (wgid % nig) / gsz; u.aux = 0; return true;
    }
    __device__ __forceinline__ int pitch_a() const { return K * 2; }
    __device__ __forceinline__ int pitch_b() const { return K * 2; }
    __device__ __forceinline__ const char* a_ptr(const Unit& u) const { return (const char*)A + (size_t)u.pm * BM * K * 2; }
    __device__ __forceinline__ const char* b_ptr(const Unit& u) const { return (const char*)Bt + (size_t)(u.pm >> 5) * bstride + (size_t)u.pn * BM * K * 2; }
    __device__ __forceinline__ unsigned a_row(const Unit&, int r) const { return (unsigned)r; }
};
template <int TYPE>
struct CrossPre {
    static constexpr bool GATHER = false;
    const f16* KVC; const f16* W; int c;
    __device__ bool next(int i, Unit& u) const { if (i > 0 || c < 0 || c >= 64) return false; u.pm = c >> 3; u.pn = c & 7; u.aux = TYPE; return true; }
    __device__ __forceinline__ int pitch_a() const { return TYPE == 0 ? 2 * DM * 2 : DM * 2; }
    __device__ __forceinline__ int pitch_b() const { return TYPE == 0 ? DM * 2 : 2 * DM * 2; }
    __device__ __forceinline__ const char* kv(const Unit& u) const { return (const char*)(KVC + (size_t)((u.pm >> 2) * MEML) * (2 * DM) + (TYPE == 0 ? 0 : DM) + (u.pm & 3) * CD); }
    __device__ __forceinline__ const char* w(const Unit& u) const { return (const char*)(W + (size_t)(u.pn * 256) * DM + (u.pm & 3) * CD); }
    __device__ __forceinline__ const char* a_ptr(const Unit& u) const { return TYPE == 0 ? kv(u) : w(u); }
    __device__ __forceinline__ const char* b_ptr(const Unit& u) const { return TYPE == 0 ? w(u) : kv(u); }
    __device__ __forceinline__ unsigned a_row(const Unit&, int r) const { return (unsigned)r; }
};
typedef int i32x4 __attribute__((ext_vector_type(4)));
typedef int i32x8 __attribute__((ext_vector_type(8)));
template <class Epi, class Sched, bool MIDSCALE = false, bool FP8 = false, bool SP2 = true>
__device__ __forceinline__ void gemm_phase(LAS unsigned char* lds, const int KB, const Sched& S, const Epi& E, LAS float* msl = nullptr) {
    const int tid = opaque_tid(), wid = __builtin_amdgcn_readfirstlane(tid >> 6), lane = tid & 63, wr = wid >> 2, wc = wid & 3, fr = lane & 15, fq = lane >> 4;
    const int nt = KB / 128, pitchA = S.pitch_a(), pitchB = S.pitch_b();
    int sR[2], sC[2]; unsigned voffB[2];
#pragma unroll
    for (int i = 0; i < 2; ++i) { int R, C; stage_rc(tid * 16 + i * 8192, R, C); const int Rb = Epi::PERM ? ((R & ~31) + perm32(R & 31)) : R; sR[i] = R; sC[i] = C; voffB[i] = (unsigned)(Rb * pitchB + C * 2); }
    const size_t kstep = (size_t)(BK * 2);
    const size_t hstepB = (size_t)HALF * pitchB;
    const unsigned ldsw = (unsigned)wid * 1024u;
    const int aoff = lds_byte(wr * 64 + fr, fq * 8), boff = lds_byte(wc * 32 + fr, fq * 8);
#define PG8_SA(b, h) (((b) * 2 + (h)) * HTB)
#define PG8_SB(b, h) ((4 + (b) * 2 + (h)) * HTB)
#define PG8_STAGE2(bufoff, gbase, o0, o1) do { \
        __builtin_amdgcn_global_load_lds((const unsigned*)((const char*)(gbase) + (o0)), (LAS unsigned*)(lds + (bufoff) + ldsw), 16, 0, 0); \
        __builtin_amdgcn_global_load_lds((const unsigned*)((const char*)(gbase) + (o1)), (LAS unsigned*)(lds + (bufoff) + ldsw + 8192), 16, 0, 0); } while (0)
#define PG8_STAGE(bufoff, gbase, voff) PG8_STAGE2(bufoff, gbase, (voff)[0], (voff)[1])
#define PG8_SEL(h, i) ((Sched::GATHER && last) ? vN[h][i] : vA[h][i])
#define PG8_LD8(p) __builtin_shufflevector(*(const LAS i32x4*)(p), *(const LAS i32x4*)((p) + 1024), 0, 1, 2, 3, 4, 5, 6, 7)
#define PG8_LDA(dst, b, h) do { _Pragma("unroll") for (int m = 0; m < 4; ++m) dst[m] = PG8_LD8(lds + PG8_SA(b, h) + aoff + m * 2048); } while (0)
#define PG8_LDB(dst, b, h) do { _Pragma("unroll") for (int n = 0; n < 2; ++n) dst[n] = PG8_LD8(lds + PG8_SB(b, h) + boff + n * 2048); } while (0)
#define PG8_H0(x) __builtin_bit_cast(f16x8, __builtin_shufflevector(x, x, 0, 1, 2, 3))
#define PG8_H1(x) __builtin_bit_cast(f16x8, __builtin_shufflevector(x, x, 4, 5, 6, 7))
#define PG8_MMA(ai, bj, At, Bt) do { __builtin_amdgcn_s_setprio(1); \
        if constexpr (FP8) { _Pragma("unroll") for (int m = 0; m < 4; ++m) _Pragma("unroll") for (int n = 0; n < 2; ++n) \
            asm volatile("v_mfma_f32_16x16x128_f8f6f4 %0, %1, %2, %0" : "+v"(acc[ai][bj][m][n]) : "v"(Bt[n]), "v"(At[m])); } \
        else { _Pragma("unroll") for (int m = 0; m < 4; ++m) _Pragma("unroll") for (int n = 0; n < 2; ++n) { \
            acc[ai][bj][m][n] = __builtin_amdgcn_mfma_f32_16x16x32_f16(PG8_H0(Bt[n]), PG8_H0(At[m]), acc[ai][bj][m][n], 0, 0, 0); \
            acc[ai][bj][m][n] = __builtin_amdgcn_mfma_f32_16x16x32_f16(PG8_H1(Bt[n]), PG8_H1(At[m]), acc[ai][bj][m][n], 0, 0, 0); } } \
        __builtin_amdgcn_s_setprio(0); } while (0)
#define PG8_WAIT_V(n) asm volatile("s_waitcnt vmcnt(" #n ")" ::: "memory")
#define PG8_WAIT_L(n) asm volatile("s_waitcnt lgkmcnt(" #n ")" ::: "memory")
#define PG8_BAR __builtin_amdgcn_s_barrier()
#define PG8_SCHED __builtin_amdgcn_sched_barrier(0)
#define PG8_VOFFA(dst, u) do { _Pragma("unroll") for (int _h = 0; _h < 2; ++_h) _Pragma("unroll") for (int _i = 0; _i < 2; ++_i) dst[_h][_i] = S.a_row(u, _h * HALF + sR[_i]) * (unsigned)pitchA + (unsigned)sC[_i] * 2u; } while (0)
    Unit cur, nxt; int ui = 0;
    if (!S.next(0, cur)) return;
    f32x4 acc[2][2][4][2];
#pragma unroll
    for (int a = 0; a < 2; ++a)
#pragma unroll
        for (int b = 0; b < 2; ++b)
#pragma unroll
            for (int m = 0; m < 4; ++m)
#pragma unroll
                for (int n = 0; n < 2; ++n) acc[a][b][m][n] = (f32x4){0.f, 0.f, 0.f, 0.f};
    const int one_scale = 0x7F7F7F7F;
    (void)one_scale;
    i32x8 At[4], B0[2], B1[2];
    unsigned vA[2][2], vN[2][2];
    const char* cA = S.a_ptr(cur); const char* cB = S.b_ptr(cur);
    PG8_VOFFA(vA, cur);
    if constexpr (SP2) {
        PG8_STAGE(PG8_SB(0, 0), cB, voffB); PG8_STAGE(PG8_SB(0, 1), cB + hstepB, voffB); PG8_STAGE(PG8_SA(0, 0), cA, vA[0]); PG8_STAGE(PG8_SA(0, 1), cA, vA[1]);
        if (wr == 1) PG8_BAR;
        PG8_WAIT_V(2); PG8_BAR;
        PG8_STAGE(PG8_SB(1, 0), cB + kstep, voffB); PG8_STAGE(PG8_SA(1, 0), cA + kstep, vA[0]); PG8_STAGE(PG8_SB(1, 1), cB + hstepB + kstep, voffB);
        PG8_WAIT_V(6); PG8_BAR;
    } else {
    PG8_STAGE(PG8_SB(0, 0), cB, voffB); PG8_STAGE(PG8_SA(0, 0), cA, vA[0]); PG8_STAGE(PG8_SB(0, 1), cB + hstepB, voffB); PG8_STAGE(PG8_SA(0, 1), cA, vA[1]);
    if (wr == 1) PG8_BAR;
    PG8_WAIT_V(4); PG8_BAR;
    PG8_STAGE(PG8_SB(1, 0), cB + kstep, voffB); PG8_STAGE(PG8_SA(1, 0), cA + kstep, vA[0]); PG8_STAGE(PG8_SB(1, 1), cB + hstepB + kstep, voffB);
    PG8_WAIT_V(6); PG8_BAR;
    }
    for (;;) {
        const bool has_next = S.next(ui + 1, nxt);
        const char* nA = has_next ? S.a_ptr(nxt) : cA + 2 * kstep; const char* nB = has_next ? S.b_ptr(nxt) : cB + 2 * kstep;
        if constexpr (MIDSCALE) E.midscale_store(msl, cur, tid);
#ifndef KLOOP_REP
#define KLOOP_REP 1
#endif
#ifndef KLOOP_FP8
#define KLOOP_FP8 true
#endif
        for (int kp_ = 0; kp_ < ((FP8 == KLOOP_FP8) ? KLOOP_REP : 1); ++kp_) {
        const bool lastpass = (kp_ == ((FP8 == KLOOP_FP8) ? KLOOP_REP : 1) - 1);
        if (kp_ > 0) {
#pragma unroll
            for (int a = 0; a < 2; ++a)
#pragma unroll
                for (int b = 0; b < 2; ++b)
#pragma unroll
                    for (int m = 0; m < 4; ++m)
#pragma unroll
                        for (int n = 0; n < 2; ++n) acc[a][b][m][n] = (f32x4){0.f, 0.f, 0.f, 0.f}; }
        for (int t = 0; t < nt; t += 2) {
            const bool last = (t == nt - 2);
            const char* a1 = uptr(cA + (size_t)(t + 1) * kstep);
            const char* a2 = uptr(last ? (lastpass ? nA : cA) : cA + (size_t)(t + 2) * kstep); const char* b2 = uptr(last ? (lastpass ? nB : cB) : cB + (size_t)(t + 2) * kstep);
            const char* a3 = a2 + kstep; const char* b3 = b2 + kstep;
            if constexpr (Sched::GATHER) {
                if (t == nt - 4) { if (has_next && lastpass) { PG8_VOFFA(vN, nxt); } else {
#pragma unroll
                    for (int _h = 0; _h < 2; ++_h)
#pragma unroll
                        for (int _i = 0; _i < 2; ++_i) vN[_h][_i] = vA[_h][_i]; } } }
            if constexpr (MIDSCALE) { if (t == nt / 2) {
#pragma unroll
                for (int a = 0; a < 2; ++a)
#pragma unroll
                    for (int m = 0; m < 4; ++m) { const float sc_ = msl[a * HALF + wr * 64 + m * 16 + fr];
#pragma unroll
                        for (int b = 0; b < 2; ++b)
#pragma unroll
                            for (int n = 0; n < 2; ++n) acc[a][b][m][n] = acc[a][b][m][n] * sc_; }
                PG8_SCHED; } }
            if constexpr (SP2) {
            PG8_LDB(B0, 0, 0); PG8_LDB(B1, 0, 1); PG8_SCHED; PG8_LDA(At, 0, 0); PG8_STAGE(PG8_SA(1, 1), a1, vA[1]);
            PG8_WAIT_V(8); PG8_WAIT_L(0); PG8_BAR; PG8_MMA(0, 0, At, B0); PG8_MMA(0, 1, At, B1); PG8_BAR; PG8_SCHED;
            PG8_LDA(At, 0, 1); PG8_STAGE(PG8_SB(0, 0), b2, voffB); PG8_STAGE(PG8_SB(0, 1), b2 + hstepB, voffB); PG8_STAGE2(PG8_SA(0, 0), a2, PG8_SEL(0, 0), PG8_SEL(0, 1));
            PG8_WAIT_V(8); PG8_WAIT_L(0); PG8_BAR; PG8_MMA(1, 0, At, B0); PG8_MMA(1, 1, At, B1); PG8_BAR; PG8_SCHED;
            PG8_LDB(B0, 1, 0); PG8_LDB(B1, 1, 1); PG8_SCHED; PG8_LDA(At, 1, 0); PG8_STAGE2(PG8_SA(0, 1), a2, PG8_SEL(1, 0), PG8_SEL(1, 1));
            PG8_WAIT_V(8); PG8_WAIT_L(0); PG8_BAR; PG8_MMA(0, 0, At, B0); PG8_MMA(0, 1, At, B1); PG8_BAR; PG8_SCHED;
            PG8_LDA(At, 1, 1); PG8_STAGE(PG8_SB(1, 0), b3, voffB); PG8_STAGE(PG8_SB(1, 1), b3 + hstepB, voffB); PG8_STAGE2(PG8_SA(1, 0), a3, PG8_SEL(0, 0), PG8_SEL(0, 1));
            PG8_WAIT_V(8); PG8_WAIT_L(0); PG8_BAR; PG8_MMA(1, 0, At, B0); PG8_MMA(1, 1, At, B1); PG8_BAR; PG8_SCHED;
            } else {
            PG8_LDB(B0, 0, 0); PG8_SCHED; PG8_LDA(At, 0, 0); PG8_STAGE(PG8_SA(1, 1), a1, vA[1]);
            PG8_WAIT_L(8); PG8_BAR; PG8_WAIT_L(0); PG8_MMA(0, 0, At, B0); PG8_BAR; PG8_SCHED;
            PG8_LDB(B1, 0, 1); PG8_STAGE(PG8_SB(0, 0), b2, voffB);
            PG8_BAR; PG8_WAIT_L(0); PG8_MMA(0, 1, At, B1); PG8_BAR;
            PG8_LDA(At, 0, 1); PG8_STAGE2(PG8_SA(0, 0), a2, PG8_SEL(0, 0), PG8_SEL(0, 1));
            PG8_BAR; PG8_WAIT_L(0); PG8_MMA(1, 0, At, B0); PG8_BAR; PG8_SCHED;
            PG8_STAGE(PG8_SB(0, 1), b2 + hstepB, voffB);
            PG8_WAIT_V(6); PG8_BAR; PG8_MMA(1, 1, At, B1); PG8_BAR;
            PG8_LDB(B0, 1, 0); PG8_SCHED; PG8_LDA(At, 1, 0); PG8_STAGE2(PG8_SA(0, 1), a2, PG8_SEL(1, 0), PG8_SEL(1, 1));
            PG8_WAIT_L(8); PG8_BAR; PG8_WAIT_L(0); PG8_MMA(0, 0, At, B0); PG8_BAR; PG8_SCHED;
            PG8_LDB(B1, 1, 1); PG8_STAGE(PG8_SB(1, 0), b3, voffB);
            PG8_BAR; PG8_WAIT_L(0); PG8_MMA(0, 1, At, B1); PG8_BAR;
            PG8_LDA(At, 1, 1); PG8_STAGE2(PG8_SA(1, 0), a3, PG8_SEL(0, 0), PG8_SEL(0, 1));
            PG8_BAR; PG8_WAIT_L(0); PG8_MMA(1, 0, At, B0); PG8_BAR; PG8_SCHED;
            PG8_STAGE(PG8_SB(1, 1), b3 + hstepB, voffB);
            PG8_WAIT_V(6); PG8_BAR; PG8_MMA(1, 1, At, B1); PG8_BAR;
                    }
        }
        }
        if (wr == 0) PG8_BAR;
        if constexpr (FP8) asm volatile("s_nop 15\n\ts_nop 15" ::: "memory");
#ifndef EPI_REP
#define EPI_REP 1
#endif
        for (int er_ = 0; er_ < (FP8 ? EPI_REP : 1); ++er_)
        E(acc, cur, wr, wc, fr, fq);
        if (!has_next) break;
#pragma unroll
        for (int a = 0; a < 2; ++a)
#pragma unroll
            for (int b = 0; b < 2; ++b)
#pragma unroll
                for (int m = 0; m < 4; ++m)
#pragma unroll
                    for (int n = 0; n < 2; ++n) acc[a][b][m][n] = (f32x4){0.f, 0.f, 0.f, 0.f};
        cur = nxt; cA = nA; cB = nB; ++ui;
        if (wr == 1) PG8_BAR;
        if constexpr (Sched::GATHER) {
#pragma unroll
            for (int _h = 0; _h < 2; ++_h)
#pragma unroll
                for (int _i = 0; _i < 2; ++_i) vA[_h][_i] = vN[_h][_i]; }
    }
    PG8_WAIT_V(0);
    PG8_BAR;
#undef PG8_SA
#undef PG8_SB
#undef PG8_STAGE
#undef PG8_STAGE2
#undef PG8_SEL
#undef PG8_LDA
#undef PG8_LDB
#undef PG8_MMA
#undef PG8_H0
#undef PG8_H1
#undef PG8_LD8
#undef PG8_WAIT_V
#undef PG8_WAIT_L
#undef PG8_BAR
#undef PG8_SCHED
#undef PG8_VOFFA
}
}

namespace epi {
using pg8::Unit;
typedef f32x4 Acc[2][2][4][2];
__device__ __forceinline__ float rstd_of(float ss, float inv_n) { return __builtin_amdgcn_rsqf(ss * inv_n + EPS); }
__device__ __forceinline__ float quad_sum(float s) { s += __shfl_xor(s, 16); s += __shfl_xor(s, 32); return s; }
template <int NP> __device__ __forceinline__ float ss_full(const float* p) {
    float s = 0.f;
#pragma unroll
    for (int i = 0; i < NP / 4; ++i) { const f32x4 v = *(const f32x4*)(p + 4 * i); s += (v[0] + v[1]) + (v[2] + v[3]); }
    return s;
}
template <int NP> __device__ __forceinline__ float ss_quad(const float* p, int fq) {
    return quad_sum(ss_full<NP / 4>(p + fq * (NP / 4)));
}

struct InProj {
    static constexpr bool PERM = true;
    f16* U; f16* QKV; size_t stride; int* kmax;
    __device__ __forceinline__ void operator()(const Acc& acc, const Unit& u, int wr, int wc, int fr, int fq) const {
        const int row0 = u.pm * 256 + wr * 64 + fr, colt = u.pn * 256, seg = colt >> 10, cl = colt & 1023;
        f16* base = QKV + (size_t)(seg > 0 ? seg - 1 : 0) * stride;
        float km[2] = {0.f, 0.f};
#pragma unroll
        for (int ai = 0; ai < 2; ++ai)
#pragma unroll
            for (int m = 0; m < 4; ++m) { const int row = row0 + ai * 128 + m * 16, b = row >> 13, t = row & (SEQ - 1);
#pragma unroll
                for (int bj = 0; bj < 2; ++bj) { const int col = cl + bj * 128 + wc * 32 + 8 * fq;
                    const f32x4 a0 = acc[ai][bj][m][0], a1 = acc[ai][bj][m][1];
                    const f16x8 w = pack8h(a0, a1);
                    f16* dst = (seg == 0) ? U + (((size_t)(b * NG + (col >> 4)) * SEQ + t) * SG + (col & 15)) : base + (size_t)row * 1024 + col;
                    *(f16x8*)dst = w;
                    if (seg == 2) { float sq = (a0[0] * a0[0] + a0[1] * a0[1]) + (a0[2] * a0[2] + a0[3] * a0[3]) + (a1[0] * a1[0] + a1[1] * a1[1]) + (a1[2] * a1[2] + a1[3] * a1[3]);
                        sq = quad_sum(sq); km[bj] = fmaxf(km[bj], sq); } } }
        if (seg == 2) {
#pragma unroll
            for (int bj = 0; bj < 2; ++bj) { float v = km[bj];
                v = fmaxf(v, __shfl_xor(v, 1)); v = fmaxf(v, __shfl_xor(v, 2)); v = fmaxf(v, __shfl_xor(v, 4)); v = fmaxf(v, __shfl_xor(v, 8));
                if (fr == 0 && fq == 0) { const int b = (u.pm * 256) >> 13, head = (cl >> 7) + bj; atomicMax(kmax + (b * AH + head) * 4 + wc, __float_as_int(v)); } }
        }
    }
};
struct PlainF16 {
    static constexpr bool PERM = true;
    f16* O; int ldc;
    __device__ __forceinline__ void operator()(const Acc& acc, const Unit& u, int wr, int wc, int fr, int fq) const {
        const int row0 = u.pm * 256 + wr * 64 + fr, col0 = u.pn * 256 + wc * 32 + 8 * fq;
#pragma unroll
        for (int ai = 0; ai < 2; ++ai)
#pragma unroll
            for (int m = 0; m < 4; ++m)
#pragma unroll
                for (int bj = 0; bj < 2; ++bj)
                    *(f16x8*)(O + (size_t)(row0 + ai * 128 + m * 16) * ldc + col0 + bj * 128) = pack8h(acc[ai][bj][m][0], acc[ai][bj][m][1]);
    }
};
struct Glu {
    static constexpr bool PERM = true;
    const f16* G; const float* bglu; f16* MIX; float* ss;
    __device__ __forceinline__ void operator()(const Acc& acc, const Unit& u, int wr, int wc, int fr, int fq) const {
        const int row0 = u.pm * 256 + wr * 64 + fr, col0 = u.pn * 256 + wc * 32 + 8 * fq;
        f32x4 bv[2][2];
#pragma unroll
        for (int bj = 0; bj < 2; ++bj)
#pragma unroll
            for (int n = 0; n < 2; ++n) bv[bj][n] = *(const f32x4*)(bglu + col0 + bj * 128 + 4 * n);
        f16x8 gy[2][2];
#pragma unroll
        for (int bj = 0; bj < 2; ++bj) gy[0][bj] = *(const f16x8*)(G + (size_t)row0 * 1024 + col0 + bj * 128);
#pragma unroll
        for (int s = 0; s < 8; ++s) { const int ai = s >> 2, m = s & 3, row = row0 + ai * 128 + m * 16; float sq = 0.f;
            if (s < 7) { const int rown = row0 + ((s + 1) >> 2) * 128 + ((s + 1) & 3) * 16;
#pragma unroll
                for (int bj = 0; bj < 2; ++bj) gy[(s + 1) & 1][bj] = *(const f16x8*)(G + (size_t)rown * 1024 + col0 + bj * 128); }
#pragma unroll
            for (int bj = 0; bj < 2; ++bj) { f32x4 o[2];
#pragma unroll
                for (int n = 0; n < 2; ++n)
#pragma unroll
                    for (int i = 0; i < 4; ++i) { const float z = acc[ai][bj][m][n][i] + bv[bj][n][i]; const float v = (float)gy[s & 1][bj][4 * n + i] * __builtin_amdgcn_rcpf(1.0f + __expf(-z)); o[n][i] = v; sq += v * v; }
                *(f16x8*)(MIX + (size_t)row * 2048 + 1024 + col0 + bj * 128) = pack8h(o[0], o[1]); }
            sq = quad_sum(sq);
            if (fq == 0) ss[(size_t)row * 16 + u.pn * 4 + wc] = sq; }
    }
};
struct OutProj {
    static constexpr bool PERM = true;
    const float* X; f16* HA; const float* ss_att; const float* ss_ssm; float* ss_h; unsigned char* H8;
    __device__ __forceinline__ void midscale_store(LAS float* msl, const Unit& u, int tid) const {
        if (tid < 256) { const int row = u.pm * 256 + tid; msl[tid] = rstd_of(ss_full<8>(ss_att + (size_t)row * 8), 1.0f / 1024.f) / rstd_of(ss_full<16>(ss_ssm + (size_t)row * 16), 1.0f / 1024.f); }
    }
    __device__ __forceinline__ void operator()(const Acc& acc, const Unit& u, int wr, int wc, int fr, int fq) const {
        const int row0 = u.pm * 256 + wr * 64 + fr, col0 = u.pn * 256 + wc * 32 + 8 * fq;
        float rsv[8];
#pragma unroll
        for (int s = 0; s < 8; ++s) rsv[s] = ss_quad<16>(ss_ssm + (size_t)(row0 + (s >> 2) * 128 + (s & 3) * 16) * 16, fq);
        f32x4 xv[2][4];
#pragma unroll
        for (int q = 0; q < 4; ++q) xv[0][q] = *(const f32x4*)(X + (size_t)row0 * DM + col0 + (q >> 1) * 128 + (q & 1) * 4);
#pragma unroll
        for (int s = 0; s < 8; ++s) { const int ai = s >> 2, m = s & 3, row = row0 + ai * 128 + m * 16; const float rs = rstd_of(rsv[s], 1.0f / 1024.f); float sq = 0.f;
            if (s < 7) { const int rown = row0 + ((s + 1) >> 2) * 128 + ((s + 1) & 3) * 16;
#pragma unroll
                for (int q = 0; q < 4; ++q) xv[(s + 1) & 1][q] = *(const f32x4*)(X + (size_t)rown * DM + col0 + (q >> 1) * 128 + (q & 1) * 4); }
#pragma unroll
            for (int bj = 0; bj < 2; ++bj) { f32x4 h[2];
#pragma unroll
                for (int n = 0; n < 2; ++n) { h[n] = xv[s & 1][bj * 2 + n] + acc[ai][bj][m][n] * rs; sq += (h[n][0] * h[n][0] + h[n][1] * h[n][1]) + (h[n][2] * h[n][2] + h[n][3] * h[n][3]); }
                *(f16x8*)(HA + (size_t)row * DM + col0 + bj * 128) = pack8h(h[0], h[1]);
                *(u32x2*)(H8 + (size_t)row * DM + col0 + bj * 128) = pack8q(h[0] * XH_SCALE, h[1] * XH_SCALE); }
            sq = quad_sum(sq);
            if (fq == 0) ss_h[(size_t)row * 32 + u.pn * 4 + wc] = sq; }
    }
};
struct CrossPreOut {
    static constexpr bool PERM = true;
    unsigned char* WKT; unsigned char* VWT;
    __device__ __forceinline__ void operator()(const Acc& acc, const Unit& u, int wr, int wc, int fr, int fq) const {
        const int b = u.pm >> 2, hc = u.pm & 3, r0 = wr * 64 + fr, c0 = wc * 32 + 8 * fq;
        unsigned char* O; int ldc; float sc;
        if (u.aux == 0) { O = WKT + ((size_t)(b * 1024 + hc * 256)) * DM + u.pn * 256; ldc = DM; sc = XK_SCALE; }
        else { O = VWT + ((size_t)(b * DM + u.pn * 256)) * 1024 + hc * 256; ldc = 1024; sc = XV_SCALE; }
#pragma unroll
        for (int ai = 0; ai < 2; ++ai)
#pragma unroll
            for (int m = 0; m < 4; ++m)
#pragma unroll
                for (int bj = 0; bj < 2; ++bj)
                    *(u32x2*)(O + (size_t)(r0 + ai * 128 + m * 16) * ldc + c0 + bj * 128) = pack8q(acc[ai][bj][m][0] * sc, acc[ai][bj][m][1] * sc);
    }
};
struct CrossSoftmax {
    static constexpr bool PERM = true;
    unsigned char* P; const float* ss_h; LAS float* xch;
    __device__ __forceinline__ void operator()(const Acc& acc, const Unit& u, int wr, int wc, int fr, int fq) const {
        const int rt0 = wr * 64 + fr, row0 = u.pm * 256 + rt0, col0 = u.pn * 256 + wc * 32 + 8 * fq;
        LAS float* xm = xch; LAS float* xs = xch + 4 * 256;
        float rs[8];
#pragma unroll
        for (int s = 0; s < 8; ++s) rs[s] = rstd_of(ss_quad<32>(ss_h + (size_t)(row0 + (s >> 2) * 128 + (s & 3) * 16) * 32, fq), 1.0f / 2048.f) * (1.0f / (XH_SCALE * XK_SCALE));
#pragma unroll
        for (int s = 0; s < 8; ++s) { const int ai = s >> 2, m = s & 3; float mx = -__builtin_inff();
#pragma unroll
            for (int bj = 0; bj < 2; ++bj)
#pragma unroll
                for (int n = 0; n < 2; ++n)
#pragma unroll
                    for (int i = 0; i < 4; ++i) mx = fmaxf(mx, acc[ai][bj][m][n][i]);
            mx = fmaxf(mx, __shfl_xor(mx, 16)); mx = fmaxf(mx, __shfl_xor(mx, 32));
            if (fq == 0) xm[wc * 256 + ai * 128 + rt0 + m * 16] = mx * rs[s]; }
        asm volatile("s_waitcnt lgkmcnt(0)" ::: "memory"); __builtin_amdgcn_s_barrier(); asm volatile("" ::: "memory");
        float mrow[8];
#pragma unroll
        for (int s = 0; s < 8; ++s) { const int r = (s >> 2) * 128 + rt0 + (s & 3) * 16; mrow[s] = fmaxf(fmaxf(xm[r], xm[256 + r]), fmaxf(xm[512 + r], xm[768 + r])) * 1.4426950408889634f; }
#pragma unroll
        for (int s = 0; s < 8; ++s) { const int ai = s >> 2, m = s & 3; const float sc = rs[s] * 1.4426950408889634f; float sum = 0.f;
#pragma unroll
            for (int bj = 0; bj < 2; ++bj)
#pragma unroll
                for (int n = 0; n < 2; ++n)
#pragma unroll
                    for (int i = 0; i < 4; ++i) sum += __builtin_amdgcn_exp2f(fmaf(acc[ai][bj][m][n][i], sc, -mrow[s]));
            sum = quad_sum(sum);
            if (fq == 0) xs[wc * 256 + ai * 128 + rt0 + m * 16] = sum; }
        asm volatile("s_waitcnt lgkmcnt(0)" ::: "memory"); __builtin_amdgcn_s_barrier(); asm volatile("" ::: "memory");
#pragma unroll
        for (int s = 0; s < 8; ++s) { const int ai = s >> 2, m = s & 3, r = ai * 128 + rt0 + m * 16; const float sc = rs[s] * 1.4426950408889634f;
            const float inv = XP_SCALE * __builtin_amdgcn_rcpf((xs[r] + xs[256 + r]) + (xs[512 + r] + xs[768 + r]));
#pragma unroll
            for (int bj = 0; bj < 2; ++bj) { f32x4 o[2];
#pragma unroll
                for (int n = 0; n < 2; ++n)
#pragma unroll
                    for (int i = 0; i < 4; ++i) o[n][i] = __builtin_amdgcn_exp2f(fmaf(acc[ai][bj][m][n][i], sc, -mrow[s])) * inv;
                *(u32x2*)(P + (size_t)(row0 + ai * 128 + m * 16) * 1024 + col0 + bj * 128) = pack8q(o[0], o[1]); } }
    }
};
struct CrossO {
    static constexpr bool PERM = true;
    f16* H; float* ss_h2;
    __device__ __forceinline__ void operator()(const Acc& acc, const Unit& u, int wr, int wc, int fr, int fq) const {
        const int row0 = u.pm * 256 + wr * 64 + fr, col0 = u.pn * 256 + wc * 32 + 8 * fq;
        f16x8 xv[2][2];
#pragma unroll
        for (int bj = 0; bj < 2; ++bj) xv[0][bj] = *(const f16x8*)(H + (size_t)row0 * DM + col0 + bj * 128);
#pragma unroll
        for (int s = 0; s < 8; ++s) { const int ai = s >> 2, m = s & 3, row = row0 + ai * 128 + m * 16; float sq = 0.f;
            if (s < 7) { const int rown = row0 + ((s + 1) >> 2) * 128 + ((s + 1) & 3) * 16;
#pragma unroll
                for (int bj = 0; bj < 2; ++bj) xv[(s + 1) & 1][bj] = *(const f16x8*)(H + (size_t)rown * DM + col0 + bj * 128); }
#pragma unroll
            for (int bj = 0; bj < 2; ++bj) { f32x4 h[2];
#pragma unroll
                for (int n = 0; n < 2; ++n)
#pragma unroll
                    for (int i = 0; i < 4; ++i) { h[n][i] = (float)xv[s & 1][bj][4 * n + i] + acc[ai][bj][m][n][i] * (1.0f / (XP_SCALE * XV_SCALE)); sq += h[n][i] * h[n][i]; }
                *(f16x8*)(H + (size_t)row * DM + col0 + bj * 128) = pack8h(h[0], h[1]); }
            sq = quad_sum(sq);
            if (fq == 0) ss_h2[(size_t)row * 32 + u.pn * 4 + wc] = sq; }
    }
};
struct ExpertGU {
    static constexpr bool PERM = true;
    unsigned char* ACT; const float* bgu;
    __device__ __forceinline__ void operator()(const Acc& acc, const Unit& u, int wr, int wc, int fr, int fq) const {
        const int row0 = u.pm * 256 + wr * 64 + fr, f0 = u.pn * 128 + wc * 32 + 8 * fq;
        const float* bg = bgu + (size_t)u.aux * (2 * DFF) + f0;
        f32x4 bgv[2], blv[2];
#pragma unroll
        for (int n = 0; n < 2; ++n) { bgv[n] = *(const f32x4*)(bg + 4 * n); blv[n] = *(const f32x4*)(bg + DFF + 4 * n); }
        const f32x2 winv = {WQ_INV, WQ_INV}, one2 = {1.0f, 1.0f}, kexp = {-1.702f * 1.4426950408889634f, -1.702f * 1.4426950408889634f};
#pragma unroll
        for (int ai = 0; ai < 2; ++ai)
#pragma unroll
            for (int m = 0; m < 4; ++m) { const int row = row0 + ai * 128 + m * 16; f32x4 o[2];
#pragma unroll
                for (int n = 0; n < 2; ++n)
#pragma unroll
                    for (int p = 0; p < 2; ++p) {
                        const f32x2 ag = {acc[ai][0][m][n][2 * p], acc[ai][0][m][n][2 * p + 1]}, al = {acc[ai][1][m][n][2 * p], acc[ai][1][m][n][2 * p + 1]};
                        const f32x2 bg2 = {bgv[n][2 * p], bgv[n][2 * p + 1]}, bl2 = {blv[n][2 * p], blv[n][2 * p + 1]};
                        f32x2 g = __builtin_elementwise_fma(ag, winv, bg2), l = __builtin_elementwise_fma(al, winv, bl2);
                        g[0] = fminf(g[0], 7.0f); g[1] = fminf(g[1], 7.0f);
                        l[0] = __builtin_amdgcn_fmed3f(l[0], -7.0f, 7.0f); l[1] = __builtin_amdgcn_fmed3f(l[1], -7.0f, 7.0f);
                        const f32x2 t = g * kexp;
                        f32x2 d = {__builtin_amdgcn_exp2f(t[0]), __builtin_amdgcn_exp2f(t[1])};
                        d = d + one2;
                        const f32x2 r = {__builtin_amdgcn_rcpf(d[0]), __builtin_amdgcn_rcpf(d[1])};
                        const f32x2 res = (g * r) * (l + one2);
                        o[n][2 * p] = res[0]; o[n][2 * p + 1] = res[1]; }
                *(u32x2*)(ACT + (size_t)row * DFF + f0) = pack8q(o[0], o[1]); }
    }
};
struct ExpertDown {
    static constexpr bool PERM = true;
    unsigned char* YS; const float* bdn;
    __device__ __forceinline__ void operator()(const Acc& acc, const Unit& u, int wr, int wc, int fr, int fq) const {
        const int row0 = u.pm * 256 + wr * 64 + fr, col0 = u.pn * 256 + wc * 32 + 8 * fq;
        f32x4 bv[2][2];
#pragma unroll
        for (int bj = 0; bj < 2; ++bj)
#pragma unroll
            for (int n = 0; n < 2; ++n) bv[bj][n] = *(const f32x4*)(bdn + (size_t)u.aux * DM + col0 + bj * 128 + 4 * n);
#pragma unroll
        for (int ai = 0; ai < 2; ++ai)
#pragma unroll
            for (int m = 0; m < 4; ++m)
#pragma unroll
                for (int bj = 0; bj < 2; ++bj)
                    *(u32x2*)(YS + (size_t)(row0 + ai * 128 + m * 16) * DM + col0 + bj * 128) = pack8q(acc[ai][bj][m][0] * WQ_INV + bv[bj][0], acc[ai][bj][m][1] * WQ_INV + bv[bj][1]);
    }
};
}

template <bool GATHER_>
struct MoeOrder {
    static constexpr bool GATHER = GATHER_;
    const LAS int* tab; const char* Abase; const char* Wbase; const int* rowtok; size_t wstride; int KB, nN, G, c;
    __device__ bool next(int i, pg8::Unit& u) const {
        const int npg = nN >> 2, x = c & 7, j = c >> 3, rbg = i * (G / nN) + 8 * (x / npg) + (j >> 2), pnl = 4 * (x % npg) + (j & 3), NB = tab[32];
        if (rbg >= NB) return false;
        int e = 0;
#pragma unroll
        for (int j = 1; j < NE; ++j) e += (tab[j] <= rbg) ? 1 : 0;
        u.pm = __builtin_amdgcn_readfirstlane(rbg); u.pn = __builtin_amdgcn_readfirstlane(pnl); u.aux = __builtin_amdgcn_readfirstlane(e); return true;
    }
    __device__ __forceinline__ int pitch_a() const { return KB; }
    __device__ __forceinline__ int pitch_b() const { return KB; }
    __device__ __forceinline__ const char* a_ptr(const pg8::Unit& u) const { return GATHER ? Abase : Abase + (size_t)u.pm * 256 * KB; }
    __device__ __forceinline__ const char* b_ptr(const pg8::Unit& u) const { return Wbase + (size_t)u.aux * wstride + (size_t)u.pn * 256 * KB; }
    __device__ __forceinline__ unsigned a_row(const pg8::Unit& u, int r) const {
        if (!GATHER) return (unsigned)r;
        const int slot = (u.pm - tab[u.aux]) * 256 + r;
        return slot < tab[64 + u.aux] ? (unsigned)rowtok[(size_t)u.aux * M + slot] : 0u;
    }
};

namespace fox {
constexpr float SCALE = 0.08838834764831845f;
constexpr float THR = 8.f;
constexpr int NW = 8, QBLK = 32, KVBLK = 64, QB = NW * QBLK, D = 128, PIT = 1024, OPIT = 2048;
constexpr int SHM_V = KVBLK * D * 2, SHM_K = KVBLK * D * 2;
constexpr int OFF_WS = 2 * SHM_V + 2 * SHM_K, OFF_CN = OFF_WS + NW * 96 * 4, OFF_VOTE = OFF_CN + SEQ * 4, LDS_BYTES = OFF_VOTE + 64;
constexpr float CUT = 18.0f;
typedef short s16x4 __attribute__((ext_vector_type(4)));
#define KSWZ(row, colB) ((row) * 256 + ((colB) ^ (((row) & 7) << 4)))
#define SBAR() __builtin_amdgcn_sched_barrier(0)
__device__ __forceinline__ int v_st(int k, int c) { const int kk = (k & ~0xC) | ((k & 4) << 1) | ((k & 8) >> 1); return ((kk >> 3) * 4 + (c >> 5)) * 512 + ((kk & 7) * 32 + (c & 31)) * 2; }
__device__ __forceinline__ int v_rd_base(int lane) { return ((lane & 3) << 3) | (((lane >> 2) & 3) << 6) | (((lane >> 4) & 1) << 5) | (((lane >> 5) & 1) << 8); }
constexpr int v_rd_off(int d0, int ks, int half) { return d0 * 512 + ks * 4096 + half * 2048; }
__device__ __forceinline__ int crow(int r, int hi) { return (r & 3) + 8 * (r >> 2) + 4 * hi; }
__device__ __forceinline__ void mask_tile(f32x16& p0, f32x16& p1, int dq) {
    const float NEG = -__builtin_inff();
#pragma unroll
    for (int r = 0; r < 16; ++r) {
        const int c = (r & 3) + 8 * (r >> 2);
        if (dq - c < 0) p0[r] = NEG;
        if (dq - c - 32 < 0) p1[r] = NEG;
    }
}
__device__ __forceinline__ void partialSM(f32x16& p0, f32x16& p1, float& m_reg, float& mn, float& alpha) {
    float pmax = p0[0];
#pragma unroll
    for (int r = 1; r < 16; ++r) pmax = fmaxf(pmax, p0[r]);
#pragma unroll
    for (int r = 0; r < 16; ++r) pmax = fmaxf(pmax, p1[r]);
    { auto rr = __builtin_amdgcn_permlane32_swap(__float_as_uint(pmax), __float_as_uint(pmax), false, false);
      pmax = fmaxf(__uint_as_float(rr[0]), __uint_as_float(rr[1])); }
    constexpr float C2 = 1.4426950408889634f * SCALE;
    if (__builtin_expect(__all((pmax - m_reg) * SCALE <= THR), 1)) { mn = m_reg; alpha = 1.f; }
    else { mn = fmaxf(m_reg, pmax); alpha = __builtin_amdgcn_exp2f((m_reg - mn) * C2); m_reg = mn; }
    const float mnL = -mn * C2;
#pragma unroll
    for (int r = 0; r < 16; ++r) p0[r] = fmaf(p0[r], C2, mnL);
#pragma unroll
    for (int r = 0; r < 16; ++r) p1[r] = fmaf(p1[r], C2, mnL);
#pragma unroll
    for (int r = 0; r < 16; ++r) p0[r] = __builtin_amdgcn_exp2f(p0[r]);
}
__device__ __forceinline__ void finishSM(f32x16& p0, f32x16& p1, float alpha, float& l_reg, f16x8& pa0, f16x8& pa1, f16x8& pa2, f16x8& pa3) {
#pragma unroll
    for (int r = 0; r < 16; ++r) p1[r] = __builtin_amdgcn_exp2f(p1[r]);
    float ps = 0;
#pragma unroll
    for (int r = 0; r < 16; ++r) ps += p0[r];
#pragma unroll
    for (int r = 0; r < 16; ++r) ps += p1[r];
    { auto rr = __builtin_amdgcn_permlane32_swap(__float_as_uint(ps), __float_as_uint(ps), false, false);
      ps = __uint_as_float(rr[0]) + __uint_as_float(rr[1]); }
    l_reg = l_reg * alpha + ps;
#define PK4(P, B_, OUT) do { unsigned a0 = pk2h(P[B_+0], P[B_+1]), a1 = pk2h(P[B_+2], P[B_+3]);                          \
        unsigned b0 = pk2h(P[B_+4], P[B_+5]), b1 = pk2h(P[B_+6], P[B_+7]);                                             \
        auto r0 = __builtin_amdgcn_permlane32_swap(a0, b0, false, false); auto r1 = __builtin_amdgcn_permlane32_swap(a1, b1, false, false); \
        u32x4 w = {r0[0], r1[0], r0[1], r1[1]}; OUT = __builtin_bit_cast(f16x8, w); } while (0)
    PK4(p0, 0, pa0); PK4(p0, 8, pa1); PK4(p1, 0, pa2); PK4(p1, 8, pa3);
#undef PK4
}
template <int KB>
__device__ __forceinline__ void qkt(f32x16& p0, f32x16& p1, const char* K_lds, int r32, int hi, const f16x8* qr, const LAS float* cnp) {
#pragma unroll
    for (int g = 0; g < 4; ++g) { const f32x4 a = *(const LAS f32x4*)(cnp + 8 * g), b = *(const LAS f32x4*)(cnp + 32 + 8 * g);
#pragma unroll
        for (int i = 0; i < 4; ++i) { p0[4 * g + i] = a[i]; p1[4 * g + i] = b[i]; } }
    const char* kb[4];
#pragma unroll
    for (int dd = 0; dd < 4; ++dd) kb[dd] = K_lds + KB * SHM_K + KSWZ(r32, (dd * 16 + hi * 8) * 2);
#pragma unroll
    for (int d0 = 0; d0 < 8; ++d0) { const char* a = kb[d0 & 3] + (d0 >> 2) * 128;
        f16x8 b0 = *reinterpret_cast<const f16x8*>(a);
        f16x8 b1 = *reinterpret_cast<const f16x8*>(a + 32 * 256);
        p0 = __builtin_amdgcn_mfma_f32_32x32x16_f16(b0, qr[d0], p0, 0, 0, 0);
        p1 = __builtin_amdgcn_mfma_f32_32x32x16_f16(b1, qr[d0], p1, 0, 0, 0); }
}
template <int VB>
__device__ __forceinline__ void pv_tile(f32x16* o, int vb0, f16x8 pa0, f16x8 pa1, f16x8 pa2, f16x8 pa3) {
#define TRRD(dst, off) asm volatile("ds_read_b64_tr_b16 %0, %1 offset:%2" : "=&v"(dst) : "v"(vb0), "i"(off) : "memory")
#define H8(l, h) __builtin_bit_cast(f16x8, (u32x4){__builtin_bit_cast(u32x2, l)[0], __builtin_bit_cast(u32x2, l)[1], __builtin_bit_cast(u32x2, h)[0], __builtin_bit_cast(u32x2, h)[1]})
#define PV_D0(d0) do { s16x4 l0, l1, l2, l3, h0, h1, h2, h3; constexpr int b_ = VB * SHM_V + v_rd_off(d0, 0, 0); \
        TRRD(l0, b_); TRRD(h0, b_ + 2048); TRRD(l1, b_ + 4096); TRRD(h1, b_ + 6144); TRRD(l2, b_ + 8192); TRRD(h2, b_ + 10240); TRRD(l3, b_ + 12288); TRRD(h3, b_ + 14336); \
        asm volatile("s_waitcnt lgkmcnt(0)" ::: "memory"); SBAR();   \
        o[d0] = __builtin_amdgcn_mfma_f32_32x32x16_f16(pa0, H8(l0, h0), o[d0], 0, 0, 0);   \
        o[d0] = __builtin_amdgcn_mfma_f32_32x32x16_f16(pa1, H8(l1, h1), o[d0], 0, 0, 0);   \
        o[d0] = __builtin_amdgcn_mfma_f32_32x32x16_f16(pa2, H8(l2, h2), o[d0], 0, 0, 0);   \
        o[d0] = __builtin_amdgcn_mfma_f32_32x32x16_f16(pa3, H8(l3, h3), o[d0], 0, 0, 0); } while (0)
    PV_D0(0); PV_D0(1); PV_D0(2); PV_D0(3);
#undef PV_D0
#undef H8
#undef TRRD
}
struct BlockRef { const f16* Q; const f16* K; const f16* V; f16* O; float* ss; int P0; float kb; };
struct Seam { f16x8 qr[8]; f16x8 st_v0, st_v1, st_k0, st_k1; };
#define ROW(p, k0, rr) ((p) + (size_t)((k0) + (rr)) * PIT + sc)
#define VMW() asm volatile("s_waitcnt vmcnt(0)" ::: "memory")
#define VMWN(n) asm volatile("s_waitcnt vmcnt(%0)" :: "i"(n) : "memory")
#define SLOAD_H(Kp, Vp, k0) do { S.st_v0 = *(const f16x8*)ROW(Vp, k0, sr); S.st_v1 = *(const f16x8*)ROW(Vp, k0, 32 + sr);              \
                         S.st_k0 = *(const f16x8*)ROW(Kp, k0, sr); S.st_k1 = *(const f16x8*)ROW(Kp, k0, 32 + sr); } while (0)
#define SWRITE_HK(bf) do { *(f16x8*)(K_lds + (bf) * SHM_K + kws) = S.st_k0; *(f16x8*)(K_lds + (bf) * SHM_K + kws + 32 * 256) = S.st_k1; } while (0)
#define SWRITE_HV(bf) do { *(f16x8*)(V_lds + (bf) * SHM_V + vst0) = S.st_v0; *(f16x8*)(V_lds + (bf) * SHM_V + vst1) = S.st_v1; } while (0)
#define SWRITE_H(bf) do { SWRITE_HV(bf); SWRITE_HK(bf); } while (0)
__device__ __forceinline__ int first_kb(int P0) { return P0 + QB - KVBLK; }
__device__ __forceinline__ void prime(const BlockRef& cur, const float* cneg, char* lds, Seam& S) {
    const int tid = opaque_tid(), wid = __builtin_amdgcn_readfirstlane(tid >> 6), lane = tid & 63, r32 = lane & 31, hi = lane >> 5;
    const int sr = tid >> 4, sc = (tid & 15) * 8, kws = KSWZ(sr, sc * 2); char* K_lds = lds + 2 * SHM_V;
    const int kb0 = first_kb(cur.P0);
#pragma unroll
    for (int d0 = 0; d0 < 8; ++d0) S.qr[d0] = *(const f16x8*)(cur.Q + (size_t)(cur.P0 + wid * QBLK + r32) * PIT + d0 * 16 + hi * 8);
    SLOAD_H(cur.K, cur.V, kb0);
    { float* cn = (float*)(lds + OFF_CN);
#pragma unroll
      for (int j = 0; j < 4; ++j) *(f32x4*)(cn + (tid + 512 * j) * 4) = *(const f32x4*)(cneg + (tid + 512 * j) * 4); }
    VMW(); SWRITE_HK(0);
    __syncthreads();
}
__device__ __forceinline__ void block(const BlockRef& cur, const BlockRef& nxt, int tokbase, char* lds, Seam& S) {
    const int tid = opaque_tid(), wid = __builtin_amdgcn_readfirstlane(tid >> 6), lane = tid & 63, r32 = lane & 31, hi = lane >> 5;
    const int NT = cur.P0 / KVBLK + QB / KVBLK;
    const int kbn = first_kb(nxt.P0);
    const int qlo = cur.P0 + wid * QBLK, qm = qlo + r32 - 4 * hi;
    char* V_lds = lds; char* K_lds = lds + 2 * SHM_V;
    float* ws = (float*)(lds + OFF_WS) + wid * 96; float* li_l = ws, * al_l = ws + 32, * qb_l = ws + 64;
    const LAS float* cn = (const LAS float*)(LAS char*)(lds + OFF_CN) + 4 * hi;
    float m_reg = -1e30f, l_reg = 0; f32x16 o[4] = {};
    const int sr = tid >> 4, sc = (tid & 15) * 8, vst0 = v_st(sr, sc), vst1 = v_st(32 + sr, sc), kws = KSWZ(sr, sc * 2);
    const int vb0 = (int)(uintptr_t)V_lds + v_rd_base(lane);
    { float s2 = 0.f;
#pragma unroll
      for (int d0 = 0; d0 < 8; ++d0)
#pragma unroll
          for (int e = 0; e < 8; ++e) { const float x = (float)S.qr[d0][e]; s2 += x * x; }
      auto rr = __builtin_amdgcn_permlane32_swap(__float_as_uint(s2), __float_as_uint(s2), false, false);
      if (hi == 0) qb_l[r32] = sqrtf(__uint_as_float(rr[0]) + __uint_as_float(rr[1])) * cur.kb; }
    volatile LAS unsigned* vote = (volatile LAS unsigned*)(LAS char*)(lds + OFF_VOTE);
    const f16* Kh = cur.K; const f16* Vh = cur.V;
#define RESC(a) do { if (__any((a) < 1.f)) { if (hi == 0) al_l[r32] = (a); asm volatile("s_waitcnt lgkmcnt(0)" ::: "memory");              \
                     for (int d_ = 0; d_ < 4; ++d_) for (int r = 0; r < 16; ++r) o[d_][r] *= al_l[crow(r, hi)]; } } while (0)
#define KBASE(t) ((NT - 1 - (t)) * KVBLK)
#define MASKT(P0_, P1_, t) do { const int kb_ = KBASE(t); if (kb_ + KVBLK - 1 > qlo) mask_tile(P0_, P1_, qm - kb_); } while (0)
    constexpr int NQL = 8;
#define SEAM_K0() do { VMWN(NQL); SWRITE_HK(0); SBAR(); } while (0)
    f32x16 pA0, pA1, pB0, pB1; float mnA, mnB, alA, alB; f16x8 pa0, pa1, pa2, pa3;
    SWRITE_HV(0); SBAR();
    if (NT > 1) { SLOAD_H(Kh, Vh, KBASE(1)); }
    SBAR(); qkt<0>(pA0, pA1, K_lds, r32, hi, S.qr, cn + KBASE(0));
    MASKT(pA0, pA1, 0); partialSM(pA0, pA1, m_reg, mnA, alA);
    if (NT > 1) { VMW(); SWRITE_H(1); }
    __syncthreads();
#define HALF_STEP(PX0, PX1, mnX, alX, PY0, PY1, alY, t, KB, VB, SB) do {                                                      \
        SBAR(); qkt<KB>(PX0, PX1, K_lds, r32, hi, S.qr, cn + KBASE(t));                                                       \
        finishSM(PY0, PY1, alY, l_reg, pa0, pa1, pa2, pa3); SBAR();                                                           \
        if ((t) + 1 < NT) { SLOAD_H(Kh, Vh, KBASE((t) + 1)); SBAR(); }                                                        \
        pv_tile<VB>(o, vb0, pa0, pa1, pa2, pa3); MASKT(PX0, PX1, (t)); partialSM(PX0, PX1, m_reg, mnX, alX);                  \
        __syncthreads();                                                                                                      \
        if ((t) + 1 < NT) { VMW(); SWRITE_H(SB); }                                                                            \
        RESC(alX); __syncthreads(); } while (0)
    bool broke = false;
    for (int t = 1; t + 1 < NT; t += 2) {
        HALF_STEP(pB0, pB1, mnB, alB, pA0, pA1, alA, t, 1, 0, 0);
        HALF_STEP(pA0, pA1, mnA, alA, pB0, pB1, alB, t + 1, 0, 1, 1);
        if (t + 2 < NT) {
            const float cl = *((const LAS float*)(LAS char*)(lds + OFF_CN) + KBASE(t + 2) + KVBLK - 1);
            const bool can = __all((qb_l[r32] + cl - m_reg) * SCALE < -CUT);
            if (lane == 0) vote[wid] = can ? 1u : 0u;
            asm volatile("s_waitcnt lgkmcnt(0)" ::: "memory"); __syncthreads();
            unsigned all_ = 1u;
#pragma unroll
            for (int w_ = 0; w_ < NW; ++w_) all_ &= vote[w_];
            __syncthreads();
            if (all_) { broke = true; break; }
        }
    }
    const bool even = !broke;
    if (even) { SBAR(); qkt<1>(pB0, pB1, K_lds, r32, hi, S.qr, cn + KBASE(NT - 1)); SBAR(); }
    SLOAD_H(nxt.K, nxt.V, kbn); SBAR();
#pragma unroll
    for (int d0 = 0; d0 < 8; ++d0) S.qr[d0] = *(const f16x8*)(nxt.Q + (size_t)(nxt.P0 + wid * QBLK + r32) * PIT + d0 * 16 + hi * 8);
    SBAR();
    finishSM(pA0, pA1, alA, l_reg, pa0, pa1, pa2, pa3); SBAR();
    pv_tile<0>(o, vb0, pa0, pa1, pa2, pa3);
    if (even) { MASKT(pB0, pB1, NT - 1); partialSM(pB0, pB1, m_reg, mnB, alB); __syncthreads(); RESC(alB);
        finishSM(pB0, pB1, alB, l_reg, pa0, pa1, pa2, pa3); SBAR(); pv_tile<1>(o, vb0, pa0, pa1, pa2, pa3); }
    SBAR(); SEAM_K0();
    if (hi == 0) li_l[r32] = l_reg; asm volatile("s_waitcnt lgkmcnt(0)" ::: "memory");
    f16* Ow = cur.O + (size_t)(cur.P0 + wid * QBLK) * OPIT;
#pragma unroll
    for (int r = 0; r < 16; ++r) { const int orow = crow(r, hi); const float rl = __builtin_amdgcn_rcpf(li_l[orow]); float sq = 0.f;
#pragma unroll
        for (int d0 = 0; d0 < 4; ++d0) { const float v = o[d0][r] * rl; sq += v * v;
            const float vn = __shfl_xor(v, 1);
            if ((r32 & 1) == 0) *(unsigned*)(Ow + (size_t)orow * OPIT + d0 * 32 + r32) = pk2h(v, vn); }
        sq += __shfl_xor(sq, 1); sq += __shfl_xor(sq, 2); sq += __shfl_xor(sq, 4); sq += __shfl_xor(sq, 8); sq += __shfl_xor(sq, 16);
        if (r32 == 0) cur.ss[(size_t)(tokbase + cur.P0 + wid * QBLK + orow) * 8] = sq; }
    __syncthreads();
#undef RESC
#undef KBASE
#undef MASKT
#undef SEAM_K0
#undef HALF_STEP
}
#undef ROW
#undef VMW
#undef VMWN
#undef SLOAD_H
#undef SWRITE_HK
#undef SWRITE_HV
#undef SWRITE_H
__device__ __forceinline__ void item(int bh, int x, const f16* Q, const f16* K, const f16* V, f16* MIX, float* ss_att, const float* cneg, const float* kmax, char* lds) {
    const int b = bh >> 3, h = bh & 7; const size_t base = (size_t)b * SEQ * PIT + h * AD;
    BlockRef r0, r1;
    r0.kb = sqrtf((kmax[bh * 4] + kmax[bh * 4 + 1] + kmax[bh * 4 + 2] + kmax[bh * 4 + 3]) * 1.004f);
    r0.Q = Q + base; r0.K = K + base; r0.V = V + base; r0.O = MIX + (size_t)b * SEQ * OPIT + h * AD; r0.ss = ss_att + h; r0.P0 = x * QB;
    r1 = r0; r1.P0 = (SEQ / QB - 1 - x) * QB;
    Seam S;
    prime(r0, cneg + (size_t)bh * SEQ, lds, S);
    BlockRef rz = r0; rz.P0 = 0;
    block(r0, r1, b * SEQ, lds, S);
    block(r1, rz, b * SEQ, lds, S);
}
}

namespace xat {
using namespace fox;
constexpr int CHB = 65536;
constexpr int LDS_BYTES = 2 * CHB + NW * 64 * 4;
__device__ __forceinline__ void unit(int b, int hc, int qb, const f16* QC, const f16* KVC, f16* OC, char* lds) {
    const int tid = opaque_tid(), wid = __builtin_amdgcn_readfirstlane(tid >> 6), lane = tid & 63, r32 = lane & 31, hi = lane >> 5;
    const int sr = tid >> 4, sc = (tid & 15) * 8, kws = KSWZ(sr, sc * 2), vst0 = v_st(sr, sc), vst1 = v_st(32 + sr, sc);
    const int row = b * SEQ + qb * QB + wid * QBLK + r32;
    const f16* Qrow = QC + (size_t)row * DM + hc * CD + hi * 8;
    const f16* Kb = KVC + (size_t)(b * MEML) * (2 * DM) + hc * CD + sc;
    const f16* Vb = Kb + DM;
    float* li_l = (float*)(lds + 2 * CHB) + wid * 64;
    f16x8 st[8];
#define XLOAD(P, ch) do { _Pragma("unroll") for (int kt = 0; kt < 4; ++kt) { st[2 * kt] = *(const f16x8*)((P) + (size_t)(kt * 64 + sr) * (2 * DM) + (ch) * 128); \
                                                                            st[2 * kt + 1] = *(const f16x8*)((P) + (size_t)(kt * 64 + 32 + sr) * (2 * DM) + (ch) * 128); } } while (0)
#define XWRITE_K(buf) do { _Pragma("unroll") for (int kt = 0; kt < 4; ++kt) { *(f16x8*)(lds + (buf) * CHB + kt * 16384 + kws) = st[2 * kt]; *(f16x8*)(lds + (buf) * CHB + kt * 16384 + kws + 32 * 256) = st[2 * kt + 1]; } } while (0)
#define XWRITE_V(buf) do { _Pragma("unroll") for (int kt = 0; kt < 4; ++kt) { *(f16x8*)(lds + (buf) * CHB + kt * 16384 + vst0) = st[2 * kt]; *(f16x8*)(lds + (buf) * CHB + kt * 16384 + vst1) = st[2 * kt + 1]; } } while (0)
    f32x16 p[4][2];
#pragma unroll
    for (int kt = 0; kt < 4; ++kt) { p[kt][0] = f32x16{}; p[kt][1] = f32x16{}; }
    XLOAD(Kb, 0); asm volatile("s_waitcnt vmcnt(0)" ::: "memory"); XWRITE_K(0); __syncthreads();
#pragma unroll 1
    for (int c = 0; c < 4; ++c) {
        f16x8 qr[8];
#pragma unroll
        for (int d0 = 0; d0 < 8; ++d0) qr[d0] = *(const f16x8*)(Qrow + c * 128 + d0 * 16);
        if (c < 3) XLOAD(Kb, c + 1); else XLOAD(Vb, 0);
        const char* kbuf = lds + (c & 1) * CHB;
#pragma unroll
        for (int kt = 0; kt < 4; ++kt) {
            const char* kb[4];
#pragma unroll
            for (int dd = 0; dd < 4; ++dd) kb[dd] = kbuf + kt * 16384 + KSWZ(r32, (dd * 16 + hi * 8) * 2);
#pragma unroll
            for (int d0 = 0; d0 < 8; ++d0) { const char* a = kb[d0 & 3] + (d0 >> 2) * 128;
                const f16x8 b0 = *reinterpret_cast<const f16x8*>(a), b1 = *reinterpret_cast<const f16x8*>(a + 32 * 256);
                p[kt][0] = __builtin_amdgcn_mfma_f32_32x32x16_f16(b0, qr[d0], p[kt][0], 0, 0, 0);
                p[kt][1] = __builtin_amdgcn_mfma_f32_32x32x16_f16(b1, qr[d0], p[kt][1], 0, 0, 0); }
        }
        asm volatile("s_waitcnt vmcnt(0)" ::: "memory");
        if (c < 3) XWRITE_K((c + 1) & 1); else XWRITE_V(0);
        __syncthreads();
    }
    float mx = p[0][0][0];
#pragma unroll
    for (int kt = 0; kt < 4; ++kt)
#pragma unroll
        for (int j = 0; j < 2; ++j)
#pragma unroll
            for (int r = 0; r < 16; ++r) mx = fmaxf(mx, p[kt][j][r]);
    { auto rr = __builtin_amdgcn_permlane32_swap(__float_as_uint(mx), __float_as_uint(mx), false, false); mx = fmaxf(__uint_as_float(rr[0]), __uint_as_float(rr[1])); }
    float ps = 0.f; const float mL = -mx * 1.4426950408889634f;
#pragma unroll
    for (int kt = 0; kt < 4; ++kt)
#pragma unroll
        for (int j = 0; j < 2; ++j)
#pragma unroll
            for (int r = 0; r < 16; ++r) { const float e = __builtin_amdgcn_exp2f(fmaf(p[kt][j][r], 1.4426950408889634f, mL)); p[kt][j][r] = e; ps += e; }
    { auto rr = __builtin_amdgcn_permlane32_swap(__float_as_uint(ps), __float_as_uint(ps), false, false); ps = __uint_as_float(rr[0]) + __uint_as_float(rr[1]); }
    f16x8 pa[4][4];
#define PK4(P, B_, OUT) do { unsigned a0 = pk2h(P[B_+0], P[B_+1]), a1 = pk2h(P[B_+2], P[B_+3]);                          \
        unsigned b0 = pk2h(P[B_+4], P[B_+5]), b1 = pk2h(P[B_+6], P[B_+7]);                                             \
        auto r0 = __builtin_amdgcn_permlane32_swap(a0, b0, false, false); auto r1 = __builtin_amdgcn_permlane32_swap(a1, b1, false, false); \
        u32x4 w = {r0[0], r1[0], r0[1], r1[1]}; OUT = __builtin_bit_cast(f16x8, w); } while (0)
#pragma unroll
    for (int kt = 0; kt < 4; ++kt) { PK4(p[kt][0], 0, pa[kt][0]); PK4(p[kt][0], 8, pa[kt][1]); PK4(p[kt][1], 0, pa[kt][2]); PK4(p[kt][1], 8, pa[kt][3]); }
#undef PK4
    if (hi == 0) li_l[r32] = ps;
    asm volatile("s_waitcnt lgkmcnt(0)" ::: "memory");
    float rl[16];
#pragma unroll
    for (int r = 0; r < 16; ++r) rl[r] = __builtin_amdgcn_rcpf(li_l[crow(r, hi)]);
    f16* Ow = OC + (size_t)(b * SEQ + qb * QB + wid * QBLK) * DM + hc * CD;
#pragma unroll 1
    for (int v = 0; v < 4; ++v) {
        if (v < 3) XLOAD(Vb, v + 1);
        f32x16 o[4] = {};
        const int vb0 = (int)(uintptr_t)lds + (v & 1) * CHB + v_rd_base(lane);
        pv_tile<0>(o, vb0, pa[0][0], pa[0][1], pa[0][2], pa[0][3]);
        pv_tile<1>(o, vb0, pa[1][0], pa[1][1], pa[1][2], pa[1][3]);
        pv_tile<2>(o, vb0, pa[2][0], pa[2][1], pa[2][2], pa[2][3]);
        pv_tile<3>(o, vb0, pa[3][0], pa[3][1], pa[3][2], pa[3][3]);
#pragma unroll
        for (int r = 0; r < 16; ++r) { const int orow = crow(r, hi);
#pragma unroll
            for (int d0 = 0; d0 < 4; ++d0) { const float val = o[d0][r] * rl[r]; const float vn = __shfl_xor(val, 1);
                if ((r32 & 1) == 0) *(unsigned*)(Ow + (size_t)orow * DM + v * 128 + d0 * 32 + r32) = pk2h(val, vn); } }
        if (v < 3) { asm volatile("s_waitcnt vmcnt(0)" ::: "memory"); XWRITE_V((v + 1) & 1); }
        __syncthreads();
    }
#undef XLOAD
#undef XWRITE_K
#undef XWRITE_V
}
}
#undef KSWZ
#undef SBAR

namespace ssm {
constexpr int KT_BYTES = 65 * 512;
constexpr int UST = 2064;
constexpr int OFF_U1 = 0, OFF_X = 0, OFF_KT = 34816, OFF_S = 68096, OFF_U3 = 68096, LDS_BYTES = 134144;
static_assert(OFF_X + 128 * 136 * 2 <= OFF_KT && OFF_KT + KT_BYTES <= OFF_S && OFF_S + 128 * 129 * 4 <= LDS_BYTES && OFF_U3 + 32 * UST <= LDS_BYTES && OFF_U1 + 32 * UST <= OFF_S, "ssm LDS map");
__device__ __forceinline__ float gelu_tanh(float x) {
    const float u = 0.7978845608028654f * (x + 0.044715f * x * x * x);
    const float e = __expf(2.0f * u);
    const float th = 1.0f - 2.0f * __builtin_amdgcn_rcpf(e + 1.0f);
    return 0.5f * x * (1.0f + th);
}
__device__ __forceinline__ void stage_u(const f16* src, LAS unsigned char* dst, int tid) {
    u32x4 v[8];
#pragma unroll
    for (int j = 0; j < 8; ++j) v[j] = *(const u32x4*)((const char*)src + (size_t)(tid + 512 * j) * 16);
#pragma unroll
    for (int j = 0; j < 8; ++j) { const int e = tid + 512 * j; *(LAS u32x4*)(dst + (e >> 7) * UST + (e & 127) * 16) = v[j]; }
}
__device__ __forceinline__ void unit(int b, int g, int half, const f16* U, const f16* KT, const f16* MIN, const f16* MOUT, const float* L64, f16* G, LAS unsigned char* lds) {
    const int tid = opaque_tid(), wid = __builtin_amdgcn_readfirstlane(tid >> 6), lane = tid & 63, n16 = lane & 15, kq = lane >> 4;
    const f16* Ug = U + ((size_t)(b * NG + g) * SEQ) * SG;
    const f16* KTg = KT + (size_t)g * (65 * 256); const f16* MINg = MIN + (size_t)g * (128 * 1024); const f16* MOUTg = MOUT + (size_t)g * (1024 * 128);
    LAS float* s_l = (LAS float*)(lds + OFF_S); LAS f16* x_l = (LAS f16*)(lds + OFF_X);
    const int ngrp = 2 * (half + 1);
    const int boff = n16 * UST + ((kq >> 1) * 16 + 8 * (kq & 1)) * 2;
    {
        f16x8 afr[32];
        const f16* arow = MINg + (size_t)(wid * 16 + n16) * 1024 + 8 * kq;
#pragma unroll
        for (int sp = 0; sp < 32; ++sp) afr[sp] = *(const f16x8*)(arow + sp * 32);
#pragma unroll 1
        for (int grp = 0; grp < ngrp; ++grp) {
            stage_u(Ug + (size_t)grp * 32 * 64 * SG, lds + OFF_U1, tid);
            __syncthreads();
            f32x4 acc[2] = {(f32x4){0.f, 0.f, 0.f, 0.f}, (f32x4){0.f, 0.f, 0.f, 0.f}};
#pragma unroll
            for (int sp = 0; sp < 32; ++sp)
#pragma unroll
                for (int cb = 0; cb < 2; ++cb) { const f16x8 bf = *(const LAS f16x8*)(lds + OFF_U1 + boff + cb * 16 * UST + sp * 64);
                    acc[cb] = __builtin_amdgcn_mfma_f32_16x16x32_f16(afr[sp], bf, acc[cb], 0, 0, 0); }
#pragma unroll
            for (int cb = 0; cb < 2; ++cb)
#pragma unroll
                for (int r = 0; r < 4; ++r) s_l[((grp * 2 + cb) * 16 + n16) * 129 + wid * 16 + 4 * kq + r] = acc[cb][r];
            __syncthreads();
        }
    }
    if (tid < 64) {
        const f32x2 l = *(const f32x2*)(L64 + (size_t)(g * 64 + tid) * 2);
        float xr = 0.f, xi = 0.f;
        for (int c = 0; c < 32 * ngrp; ++c) {
            x_l[c * 136 + tid] = (f16)xr; x_l[c * 136 + 64 + tid] = (f16)xi;
            const float sr = s_l[c * 129 + tid], si = s_l[c * 129 + 64 + tid];
            const float nr = l[0] * xr - l[1] * xi + sr, ni = l[0] * xi + l[1] * xr + si;
            xr = nr; xi = ni;
        }
    } else {
        for (int i = tid - 64; i < KT_BYTES / 16; i += 448) *(LAS u32x4*)(lds + OFF_KT + i * 16) = *(const u32x4*)((const char*)KTg + i * 16);
    }
    __syncthreads();
    const LAS f16* ktl = (const LAS f16*)(lds + OFF_KT) + n16 * 16 + 8 * (kq & 1);
    const int lagoff = 1 - (kq >> 1);
#pragma unroll 1
    for (int pass = 2 * half; pass < 2 * half + 2; ++pass) {
        stage_u(Ug + (size_t)pass * 32 * 64 * SG, lds + OFF_U3, tid);
        __syncthreads();
        f32x4 acc[8][2];
#pragma unroll
        for (int ti = 0; ti < 8; ++ti) { acc[ti][0] = (f32x4){0.f, 0.f, 0.f, 0.f}; acc[ti][1] = (f32x4){0.f, 0.f, 0.f, 0.f}; }
#pragma unroll 4
        for (int sp = 0; sp < 32; ++sp) {
            const int s0 = 2 * sp;
            const f16x8 b0 = *(const LAS f16x8*)(lds + OFF_U3 + boff + sp * 64);
            const f16x8 b1 = *(const LAS f16x8*)(lds + OFF_U3 + boff + 16 * UST + sp * 64);
#pragma unroll
            for (int ti = 0; ti < 8; ++ti) { const int t = wid + 8 * ti;
                int li = t - s0 + lagoff; li = li < 0 ? 0 : li;
                const f16x8 a = *(const LAS f16x8*)(ktl + li * 256);
                acc[ti][0] = __builtin_amdgcn_mfma_f32_16x16x32_f16(a, b0, acc[ti][0], 0, 0, 0);
                acc[ti][1] = __builtin_amdgcn_mfma_f32_16x16x32_f16(a, b1, acc[ti][1], 0, 0, 0); }
        }
#pragma unroll
        for (int ks = 0; ks < 4; ++ks) {
            const f16x8 b0 = *(const LAS f16x8*)(x_l + ((pass * 2 + 0) * 16 + n16) * 136 + ks * 32 + 8 * kq);
            const f16x8 b1 = *(const LAS f16x8*)(x_l + ((pass * 2 + 1) * 16 + n16) * 136 + ks * 32 + 8 * kq);
#pragma unroll
            for (int ti = 0; ti < 8; ++ti) { const int t = wid + 8 * ti;
                const f16x8 a = *(const f16x8*)(MOUTg + (size_t)(t * 16 + n16) * 128 + ks * 32 + 8 * kq);
                acc[ti][0] = __builtin_amdgcn_mfma_f32_16x16x32_f16(a, b0, acc[ti][0], 0, 0, 0);
                acc[ti][1] = __builtin_amdgcn_mfma_f32_16x16x32_f16(a, b1, acc[ti][1], 0, 0, 0); }
        }
#pragma unroll
        for (int ti = 0; ti < 8; ++ti)
#pragma unroll
            for (int j = 0; j < 2; ++j) { const int t = wid + 8 * ti, c = (pass * 2 + j) * 16 + n16; const size_t tok = (size_t)b * SEQ + 64 * c + t;
                const f32x4 y = acc[ti][j];
                u32x2 w = {pk2h(gelu_tanh(y[0]), gelu_tanh(y[1])), pk2h(gelu_tanh(y[2]), gelu_tanh(y[3]))};
                *(u32x2*)(G + tok * SSMW + g * SG + 4 * kq) = w; }
        __syncthreads();
    }
}
}

constexpr size_t MiB = 1u << 20;
constexpr size_t WS_CTL = 0, CTL_ZERO_BYTES = 65536;
constexpr int CW_BAR = 1024, CW_CNT = CW_BAR + XCD_BAR_WORDS, CNT_STRIDE = 32, CW_KMAX = 15424, CW_CLAIM = 15488;
static_assert(CW_BAR + 4 * XCD_BAR_WORDS <= CW_KMAX && NE * CNT_STRIDE <= XCD_BAR_WORDS && (CW_CLAIM + 128) * 4 <= (int)CTL_ZERO_BYTES, "CTL map");
constexpr size_t WS_WIN = 1 * MiB;
constexpr size_t WS_WGLU = WS_WIN + (size_t)4096 * 2048 * 2;
constexpr size_t WS_WOUT = WS_WGLU + (size_t)1024 * 1024 * 2;
constexpr size_t WS_WCQ = WS_WOUT + (size_t)2048 * 2048 * 2;
constexpr size_t WS_WCKV = WS_WCQ + (size_t)2048 * 2048 * 2;
constexpr size_t WS_WCO = WS_WCKV + (size_t)4096 * 2048 * 2;
constexpr size_t WS_WR = WS_WCO + (size_t)2048 * 2048 * 2;
constexpr size_t WS_KT = WS_WR + (size_t)32 * 2048 * 2;
constexpr size_t WS_MIN = WS_KT + (size_t)64 * 65 * 256 * 2;
constexpr size_t WS_MOUT = WS_MIN + (size_t)64 * 128 * 1024 * 2;
constexpr size_t WS_L64 = WS_MOUT + (size_t)64 * 1024 * 128 * 2;
constexpr size_t WS_FL = WS_L64 + (size_t)64 * 64 * 8;
constexpr size_t WS_CNEG = WS_FL + (size_t)M * 8 * 4;
constexpr size_t WS_ROUTE = WS_CNEG + (size_t)16 * SEQ * 4;
constexpr size_t WS_ROWTOK = WS_ROUTE + (size_t)M * 4 * 16;
constexpr size_t WS_MEMN = WS_ROWTOK + (size_t)NE * M * 4;
constexpr size_t WS_KVC = WS_MEMN + (size_t)512 * 2048 * 2;
constexpr size_t WS_SSATT = WS_KVC + (size_t)512 * 4096 * 2;
constexpr size_t WS_SSSSM = WS_SSATT + (size_t)M * 8 * 4;
constexpr size_t WS_SSH = WS_SSSSM + (size_t)M * 16 * 4;
constexpr size_t WS_SSH2 = WS_SSH + (size_t)M * 32 * 4;
constexpr size_t WS_XN = 128 * MiB;
constexpr size_t WS_U = WS_XN + 64 * MiB;
constexpr size_t WS_Q = WS_U + 32 * MiB, WS_K = WS_Q + 32 * MiB, WS_V = WS_K + 32 * MiB;
constexpr size_t WS_G = WS_V + 32 * MiB;
constexpr size_t WS_MIX = WS_G + 32 * MiB;
constexpr size_t WS_H = WS_MIX + 64 * MiB;
constexpr size_t WS_HA = WS_H + 128 * MiB;
constexpr size_t WS_QC = WS_HA + 64 * MiB;
constexpr size_t WS_PB = WS_QC, WS_WKT = WS_QC + 32 * MiB, WS_VWT = WS_QC + 40 * MiB;
constexpr size_t WS_OC = WS_QC + 64 * MiB, WS_H8 = WS_OC;
constexpr size_t WS_X2N = WS_OC + 64 * MiB;
constexpr size_t WS_ACT = WS_X2N + 64 * MiB;
constexpr size_t WS_YS = WS_ACT + 288 * MiB;
constexpr size_t WS_WGU = WS_YS + 288 * MiB;
constexpr size_t WS_WDN = WS_WGU + 512 * MiB;
constexpr size_t WS_END = WS_WDN + 256 * MiB;
static_assert(WS_SSH2 + (size_t)M * 32 * 4 <= WS_XN, "small tables fit below 128 MiB");

constexpr int RING_BYTES = 134144 + 0;
constexpr int RING_CAP = 135168;
constexpr int MISC_OFF = RING_CAP;
constexpr int MOE_TAB_OFF = MISC_OFF + 64;
constexpr int XCH_OFF = MISC_OFF + 2048;
constexpr int MSC_OFF = MISC_OFF + 1024;
constexpr int LDS_BYTES = 147456;
static_assert(ssm::LDS_BYTES <= RING_CAP && xat::LDS_BYTES <= RING_CAP && fox::LDS_BYTES <= RING_CAP && pg8::STAGE_BYTES <= RING_CAP && MOE_TAB_OFF + 128 * 4 <= MSC_OFF && MSC_OFF + 1024 <= XCH_OFF && XCH_OFF + 8192 <= LDS_BYTES, "LDS map");

constexpr int NWAVES = 8;

__device__ __forceinline__ void titem_load(f32x4 (&v)[16], const float* W, int ldw, int k0, int c0, int lane) {
    const int kr = lane >> 4, n4 = (lane & 15) * 4;
#pragma unroll
    for (int i = 0; i < 16; ++i) v[i] = __builtin_nontemporal_load((const f32x4*)(W + (size_t)(k0 + 4 * i + kr) * ldw + c0 + n4));
}
template <bool Q8, class RowMap>
__device__ __forceinline__ void titem_store(const f32x4 (&v)[16], int k0, int c0, void* WT, int K, const RowMap& rm, const float* kscale, float mul, LAS float* scr, int lane) {
    const int kr = lane >> 4, n4 = (lane & 15) * 4;
#pragma unroll
    for (int i = 0; i < 16; ++i) { LAS float* d = scr + (4 * i + kr) * 65 + n4; d[0] = v[i][0]; d[1] = v[i][1]; d[2] = v[i][2]; d[3] = v[i][3]; }
    LDS_WAIT(); asm volatile("" ::: "memory");
    const int c = lane & 7;
    float ks[8];
#pragma unroll
    for (int j = 0; j < 8; ++j) ks[j] = kscale ? kscale[k0 + 8 * c + j] * mul : mul;
#pragma unroll
    for (int j = 0; j < 8; ++j) { const int n = (lane >> 3) + 8 * j; const LAS float* s = scr + (8 * c) * 65 + n;
        if constexpr (Q8) { *(u32x2*)((unsigned char*)WT + (size_t)rm(c0 + n) * K + k0 + 8 * c) =
                pack8q((f32x4){s[0 * 65] * ks[0], s[1 * 65] * ks[1], s[2 * 65] * ks[2], s[3 * 65] * ks[3]}, (f32x4){s[4 * 65] * ks[4], s[5 * 65] * ks[5], s[6 * 65] * ks[6], s[7 * 65] * ks[7]}); }
        else { u32x4 o; o.x = pk2h(s[0 * 65] * ks[0], s[1 * 65] * ks[1]); o.y = pk2h(s[2 * 65] * ks[2], s[3 * 65] * ks[3]); o.z = pk2h(s[4 * 65] * ks[4], s[5 * 65] * ks[5]); o.w = pk2h(s[6 * 65] * ks[6], s[7 * 65] * ks[7]);
            *(u32x4*)((f16*)WT + (size_t)rm(c0 + n) * K + k0 + 8 * c) = o; } }
    LDS_WAIT(); asm volatile("" ::: "memory");
}
__device__ __forceinline__ void qitem_load(f32x4 (&v)[16], const float* W, int ldw, int k0, int c0, int lane) {
    const int kr = lane >> 3, n4 = (lane & 7) * 4;
#pragma unroll
    for (int i = 0; i < 16; ++i) v[i] = __builtin_nontemporal_load((const f32x4*)(W + (size_t)(k0 + 8 * i + kr) * ldw + c0 + n4));
}
__device__ __forceinline__ void tr4x4_b8(unsigned a, unsigned b, unsigned c, unsigned d, unsigned (&o)[4]) {
    const unsigned ab0 = __builtin_amdgcn_perm(b, a, 0x05010400), ab1 = __builtin_amdgcn_perm(b, a, 0x07030602);
    const unsigned cd0 = __builtin_amdgcn_perm(d, c, 0x05010400), cd1 = __builtin_amdgcn_perm(d, c, 0x07030602);
    o[0] = __builtin_amdgcn_perm(cd0, ab0, 0x05040100); o[1] = __builtin_amdgcn_perm(cd0, ab0, 0x07060302);
    o[2] = __builtin_amdgcn_perm(cd1, ab1, 0x05040100); o[3] = __builtin_amdgcn_perm(cd1, ab1, 0x07060302);
}
template <class RowMap>
__device__ __forceinline__ void qitem_store(const f32x4 (&v)[16], int k0, int c0, unsigned char* WT, int K, const RowMap& rm, float mul, LAS float* scr, int lane) {
    LAS unsigned* t8 = (LAS unsigned*)scr;
    const int kr = lane >> 3, nq = lane & 7;
#pragma unroll
    for (int i = 0; i < 16; ++i) { const f32x4 x = v[i] * mul; unsigned w = 0;
        w = __builtin_amdgcn_cvt_pk_fp8_f32(x[0], x[1], w, false); w = __builtin_amdgcn_cvt_pk_fp8_f32(x[2], x[3], w, true);
        t8[(8 * i + kr) * 9 + nq] = w; }
    LDS_WAIT(); asm volatile("" ::: "memory");
    const int ng = lane & 7, c = lane >> 3;
    unsigned out[4][4];
#pragma unroll
    for (int blk = 0; blk < 4; ++blk) { const LAS unsigned* p = t8 + (16 * c + 4 * blk) * 9 + ng; unsigned o[4];
        tr4x4_b8(p[0], p[9], p[18], p[27], o);
#pragma unroll
        for (int j = 0; j < 4; ++j) out[j][blk] = o[j]; }
#pragma unroll
    for (int j = 0; j < 4; ++j) __builtin_nontemporal_store((u32x4){out[j][0], out[j][1], out[j][2], out[j][3]}, (u32x4*)(WT + (size_t)rm(c0 + 4 * ng + j) * K + k0 + 16 * c));
    LDS_WAIT(); asm volatile("" ::: "memory");
}
template <bool Q8, class RowMap>
__device__ __forceinline__ void transpose_item(const float* W, int ldw, int k0, int c0, void* WT, int K, const RowMap& rm, const float* kscale, float mul, LAS float* scr, int lane) {
    f32x4 v[16]; titem_load(v, W, ldw, k0, c0, lane); titem_store<Q8>(v, k0, c0, WT, K, rm, kscale, mul, scr, lane);
}
struct RowId { __device__ __forceinline__ int operator()(int n) const { return n; } };
struct RowGU { __device__ __forceinline__ int operator()(int n) const { const int lin = n >= DFF, f = lin ? n - DFF : n; return (f >> 7) * 256 + lin * 128 + (f & 127); } };

__device__ __forceinline__ void norm_row_f16(const float* xrow, const float* gain, f16* orow, int lane, float (&xn)[32]) {
    float s = 0.f;
#pragma unroll
    for (int j = 0; j < 4; ++j) { const f32x4 a = *(const f32x4*)(xrow + 8 * (lane + 64 * j)), b = *(const f32x4*)(xrow + 8 * (lane + 64 * j) + 4);
#pragma unroll
        for (int i = 0; i < 4; ++i) { xn[8 * j + i] = a[i]; xn[8 * j + 4 + i] = b[i]; s += a[i] * a[i] + b[i] * b[i]; } }
    const float rs = 1.0f / sqrtf(wave_sum(s) * (1.0f / DM) + EPS);
#pragma unroll
    for (int j = 0; j < 4; ++j) { const f32x4 ga = *(const f32x4*)(gain + 8 * (lane + 64 * j)), gb = *(const f32x4*)(gain + 8 * (lane + 64 * j) + 4);
#pragma unroll
        for (int i = 0; i < 4; ++i) { xn[8 * j + i] *= rs * ga[i]; xn[8 * j + 4 + i] *= rs * gb[i]; }
        *(f16x8*)(orow + 8 * (lane + 64 * j)) = pack8h((f32x4){xn[8 * j], xn[8 * j + 1], xn[8 * j + 2], xn[8 * j + 3]}, (f32x4){xn[8 * j + 4], xn[8 * j + 5], xn[8 * j + 6], xn[8 * j + 7]}); }
}

__device__ __forceinline__ void ssm_tables(int g, int part, const float* lam_re, const float* lam_im, const float* log_step, const float* b_re, const float* b_im, const float* c_re, const float* c_im,
                                           const float* d_skip, f16* KT, f16* MIN, f16* MOUT, float* L64, LAS unsigned char* lds, int tid) {
    constexpr int PWS = 65, CBS = 80;
    LAS f32x2* Pw = (LAS f32x2*)lds;
    LAS f32x2* Bb = Pw + 65 * PWS;
    LAS f32x2* Cc = Bb + 64 * 16;
    LAS f32x2* Cf = Cc + 16 * 64;
    LAS float* CB = (LAS float*)(Cf + 64);
    const double dt = exp((double)log_step[g]);
    if (tid < 64) { const int p = tid; const double lr = lam_re[g * 64 + p], li = lam_im[g * 64 + p];
        const double mag = exp(lr * dt), br = mag * cos(li * dt), bi = mag * sin(li * dt);
        double pr = 1.0, pi = 0.0;
        for (int j = 0; j <= 64; ++j) { Pw[j * PWS + p] = (f32x2){(float)pr, (float)pi}; const double nr = pr * br - pi * bi, ni = pr * bi + pi * br; pr = nr; pi = ni; }
        const double nr = br - 1.0, ni = bi, den = lr * lr + li * li;
        Cf[p] = (f32x2){(float)((nr * lr + ni * li) / den), (float)((ni * lr - nr * li) / den)}; }
    __syncthreads();
    for (int i = tid; i < 64 * 16; i += 512) { const int p = i >> 4; const f32x2 cf = Cf[p];
        const float br = b_re[(size_t)g * 1024 + i], bi = b_im[(size_t)g * 1024 + i];
        Bb[i] = (f32x2){cf[0] * br - cf[1] * bi, cf[0] * bi + cf[1] * br}; }
    for (int i = tid; i < 16 * 64; i += 512) Cc[i] = (f32x2){c_re[(size_t)g * 1024 + i], c_im[(size_t)g * 1024 + i]};
    __syncthreads();
    f16* KTg = KT + (size_t)g * (65 * 256);
    for (int i = tid; i < 64 * 64; i += 512) { const int p = i >> 6, c = i & 63, cg = 64 * part + c; const f32x2 B = Bb[p * 16 + (cg & 15)], C = Cc[(cg >> 4) * 64 + p];
        CB[(2 * p) * CBS + c] = C[0] * B[0] - C[1] * B[1]; CB[(2 * p + 1) * CBS + c] = -(C[0] * B[1] + C[1] * B[0]); }
    if (tid < 64) KTg[64 * part + tid] = (f16)0.f;
    __syncthreads();
    { const int lane = tid & 63, wv = tid >> 6, l16 = lane & 15, kq = lane >> 4; const LAS float* Pf = (const LAS float*)Pw;
#pragma unroll
      for (int q = 0; q < 2; ++q) { const int mt = (2 * wv + q) >> 2, nt = (2 * wv + q) & 3; f32x4 acc = {0.f, 0.f, 0.f, 0.f};
          const LAS float* ap = Pf + (16 * mt + l16) * (2 * PWS) + kq; const LAS float* bp = CB + kq * CBS + 16 * nt + l16;
#pragma unroll 8
          for (int ks = 0; ks < 32; ++ks) acc = __builtin_amdgcn_mfma_f32_16x16x4f32(ap[4 * ks], bp[4 * ks * CBS], acc, 0, 0, 0);
          const int cg = 64 * part + 16 * nt + l16;
#pragma unroll
          for (int r = 0; r < 4; ++r) { const int j = 16 * mt + 4 * kq + r; float v = acc[r];
              if (j == 0 && (cg >> 4) == (cg & 15)) v += d_skip[g * 16 + (cg >> 4)];
              KTg[(j + 1) * 256 + cg] = (f16)v; } } }
    f16* MINg = MIN + (size_t)g * (128 * 1024);
    for (int v = part * 4096 + tid; v < (part + 1) * 4096; v += 512) { const int row = v >> 7, cv = v & 127, ri = row >> 6, p = row & 63, s_ = cv >> 1, h0 = (cv & 1) * 8;
        const f32x2 P = Pw[(63 - s_) * PWS + p]; float o[8];
#pragma unroll
        for (int q = 0; q < 8; ++q) { const f32x2 B = Bb[p * 16 + h0 + q]; o[q] = ri == 0 ? P[0] * B[0] - P[1] * B[1] : P[0] * B[1] + P[1] * B[0]; }
        *(f16x8*)(MINg + (size_t)row * 1024 + cv * 8) = pack8h((f32x4){o[0], o[1], o[2], o[3]}, (f32x4){o[4], o[5], o[6], o[7]}); }
    f16* MOUTg = MOUT + (size_t)g * (1024 * 128);
    for (int v = part * 4096 + tid; v < (part + 1) * 4096; v += 512) { const int row = v >> 4, cv = v & 15, t = row >> 4, ho = row & 15, ri = cv >> 3, p0 = (cv & 7) * 8; float o[8];
#pragma unroll
        for (int q = 0; q < 8; ++q) { const f32x2 P = Pw[(t + 1) * PWS + p0 + q], C = Cc[ho * 64 + p0 + q]; o[q] = ri == 0 ? C[0] * P[0] - C[1] * P[1] : -(C[0] * P[1] + C[1] * P[0]); }
        *(f16x8*)(MOUTg + (size_t)row * 128 + cv * 8) = pack8h((f32x4){o[0], o[1], o[2], o[3]}, (f32x4){o[4], o[5], o[6], o[7]}); }
    if (part == 0 && tid < 64) *(f32x2*)(L64 + (size_t)(g * 64 + tid) * 2) = Pw[64 * PWS + tid];
    __syncthreads();
}

__device__ __forceinline__ void cumsum_unit(int bh, const float* FL, float* CNEG, LAS unsigned char* lds, int tid) {
    const int b = bh >> 3, h = bh & 7; LAS float* tot = (LAS float*)lds;
    float v[16]; float run = 0.f;
#pragma unroll
    for (int i = 0; i < 16; ++i) { const float x = FL[((size_t)b * SEQ + 16 * tid + i) * 8 + h];
        const float ls = fminf(x, 0.f) - log1pf(__expf(-fabsf(x))); run += ls; v[i] = run; }
    tot[tid] = run; __syncthreads();
    for (int off = 1; off < 512; off <<= 1) { const float a = tid >= off ? tot[tid - off] : 0.f; __syncthreads(); tot[tid] += a; __syncthreads(); }
    const float base = tid > 0 ? tot[tid - 1] : 0.f;
#pragma unroll
    for (int i = 0; i < 16; ++i) CNEG[(size_t)bh * SEQ + 16 * tid + i] = -(base + v[i]) * 11.313708498984761f;
    __syncthreads();
}

struct RouteRec { int e, slot; float gate; int pad; };
__device__ __forceinline__ void router_task(int task, int half, LAS float* pl, const f16* H2, const float* ss_h2, const float* g_moe, const f16* WR, const float* b_router,
                                            unsigned char* X2N, RouteRec* ROUTE, int* ROWTOK, unsigned* cnt, LAS float* lg, int lane, bool commit = true) {
    const int n16 = lane & 15, kq = lane >> 4, tok = task * 16 + n16;
    const float rs = 1.0f / sqrtf(epi::ss_quad<32>(ss_h2 + (size_t)tok * 32, kq) * (1.0f / DM) + EPS);
    f32x4 acc0 = {0.f, 0.f, 0.f, 0.f}, acc1 = {0.f, 0.f, 0.f, 0.f};
    const f16* hrow = H2 + (size_t)tok * DM + 8 * kq; unsigned char* xrow = X2N + (size_t)tok * DM + 8 * kq;
    const f16* w0 = WR + (size_t)n16 * DM + 8 * kq; const f16* w1 = w0 + (size_t)16 * DM;
#pragma unroll 8
    for (int ks = 32 * half; ks < 32 * half + 32; ++ks) {
        const f16x8 hv = *(const f16x8*)(hrow + ks * 32);
        const f32x4 a = {(float)hv[0], (float)hv[1], (float)hv[2], (float)hv[3]}, b = {(float)hv[4], (float)hv[5], (float)hv[6], (float)hv[7]};
        const f32x4 ga = *(const f32x4*)(g_moe + ks * 32 + 8 * kq), gb = *(const f32x4*)(g_moe + ks * 32 + 8 * kq + 4);
        const f32x4 xa = a * ga * rs, xb = b * gb * rs;
        const f16x8 xh = pack8h(xa, xb);
        *(u32x2*)(xrow + ks * 32) = pack8q(xa, xb);
        const f16x8 b0 = *(const f16x8*)(w0 + ks * 32), b1 = *(const f16x8*)(w1 + ks * 32);
        acc0 = __builtin_amdgcn_mfma_f32_16x16x32_f16(xh, b0, acc0, 0, 0, 0);
        acc1 = __builtin_amdgcn_mfma_f32_16x16x32_f16(xh, b1, acc1, 0, 0, 0);
    }
    if (half == 1) { *(LAS f32x4*)(pl + lane * 8) = acc0; *(LAS f32x4*)(pl + lane * 8 + 4) = acc1; }
    __syncthreads();
    if (half == 0) { acc0 = acc0 + *(const LAS f32x4*)(pl + lane * 8); acc1 = acc1 + *(const LAS f32x4*)(pl + lane * 8 + 4);
#pragma unroll
        for (int r = 0; r < 4; ++r) { lg[(4 * kq + r) * 33 + n16] = acc0[r]; lg[(4 * kq + r) * 33 + 16 + n16] = acc1[r]; } }
    LDS_WAIT(); asm volatile("" ::: "memory");
    if (lane < 16 && commit && half == 0) {
        float v[NE];
#pragma unroll
        for (int e = 0; e < NE; ++e) v[e] = lg[lane * 33 + e] + b_router[e];
        float tv[TOPK]; int te[TOPK];
#pragma unroll
        for (int j = 0; j < TOPK; ++j) { float best = -__builtin_inff(); int bi = 0;
#pragma unroll
            for (int e = 0; e < NE; ++e) { const bool gt = v[e] > best; best = gt ? v[e] : best; bi = gt ? e : bi; }
            tv[j] = best; te[j] = bi;
#pragma unroll
            for (int e = 0; e < NE; ++e) v[e] = (e == bi) ? -__builtin_inff() : v[e]; }
        float ex[TOPK], sum = 0.f;
#pragma unroll
        for (int j = 0; j < TOPK; ++j) { ex[j] = __expf(tv[j] - tv[0]); sum += ex[j]; }
        const float inv = 1.0f / sum; const int t = task * 16 + lane;
#pragma unroll
        for (int j = 0; j < TOPK; ++j) { const int slot = (int)atomicAdd(cnt + te[j] * CNT_STRIDE, 1u);
            ROWTOK[(size_t)te[j] * M + slot] = t;
            RouteRec rr; rr.e = te[j]; rr.slot = slot; rr.gate = ex[j] * inv; rr.pad = 0; ROUTE[(size_t)t * TOPK + j] = rr; }
    }
    LDS_WAIT(); asm volatile("" ::: "memory");
}

__device__ __forceinline__ void moe_table(const unsigned* cnt, LAS int* tab, int tid) {
    __syncthreads();
    if (tid == 0) { int run = 0;
        for (int e = 0; e < NE; ++e) { const int c = (int)cnt[e * CNT_STRIDE]; tab[e] = run; tab[64 + e] = c; run += (c + 255) >> 8; }
        tab[32] = run; }
    __syncthreads();
}

__device__ __forceinline__ void final_row(int tok, const f16* H2, const unsigned char* YS, const RouteRec* ROUTE, const LAS int* tab, const float* g_final, float* out, int lane) {
    float v[32];
#pragma unroll
    for (int j = 0; j < 4; ++j) { const f16x8 hv = *(const f16x8*)(H2 + (size_t)tok * DM + 8 * (lane + 64 * j));
#pragma unroll
        for (int i = 0; i < 8; ++i) v[8 * j + i] = (float)hv[i]; }
#pragma unroll
    for (int q = 0; q < TOPK; ++q) { const RouteRec rr = ROUTE[(size_t)tok * TOPK + q]; const size_t row = (size_t)tab[rr.e] * 256 + rr.slot;
#pragma unroll
        for (int j = 0; j < 4; ++j) { const u32x2 y = *(const u32x2*)(YS + row * DM + 8 * (lane + 64 * j));
            const f32x2 y0 = __builtin_amdgcn_cvt_pk_f32_fp8(y[0], false), y1 = __builtin_amdgcn_cvt_pk_f32_fp8(y[0], true), y2 = __builtin_amdgcn_cvt_pk_f32_fp8(y[1], false), y3 = __builtin_amdgcn_cvt_pk_f32_fp8(y[1], true);
            v[8 * j + 0] += rr.gate * y0[0]; v[8 * j + 1] += rr.gate * y0[1]; v[8 * j + 2] += rr.gate * y1[0]; v[8 * j + 3] += rr.gate * y1[1];
            v[8 * j + 4] += rr.gate * y2[0]; v[8 * j + 5] += rr.gate * y2[1]; v[8 * j + 6] += rr.gate * y3[0]; v[8 * j + 7] += rr.gate * y3[1]; } }
    float s = 0.f;
#pragma unroll
    for (int i = 0; i < 32; ++i) s += v[i] * v[i];
    const float rs = 1.0f / sqrtf(wave_sum(s) * (1.0f / DM) + EPS);
#pragma unroll
    for (int j = 0; j < 4; ++j) { const f32x4 ga = *(const f32x4*)(g_final + 8 * (lane + 64 * j)), gb = *(const f32x4*)(g_final + 8 * (lane + 64 * j) + 4);
        f32x4 oa, ob;
#pragma unroll
        for (int i = 0; i < 4; ++i) { oa[i] = v[8 * j + i] * rs * ga[i]; ob[i] = v[8 * j + 4 + i] * rs * gb[i]; }
        *(f32x4*)(out + (size_t)tok * DM + 8 * (lane + 64 * j)) = oa; *(f32x4*)(out + (size_t)tok * DM + 8 * (lane + 64 * j) + 4) = ob; }
}

#ifndef MK_N_LAUNCHES
#define MK_N_LAUNCHES 1
#endif
constexpr int N_PHASES = 12;
struct Args { const float* in[31]; float* out; unsigned char* ws; int ph_lo, ph_hi, li, pad; };
static_assert(sizeof(Args) == 280 && __builtin_offsetof(Args, out) == 248 && __builtin_offsetof(Args, ws) == 256, "kernarg layout used by INP/OUTP/PHASE_WS");
enum { I_X = 0, I_MEM, I_GMIX, I_WIN, I_BF, I_LRE, I_LIM, I_LSTEP, I_BRE, I_BIM, I_CRE, I_CIM, I_DSKIP, I_WGLU, I_BGLU, I_GATT, I_GSSM, I_WOUT, I_GCROSS, I_GMEM,
       I_WCQ, I_WCKV, I_WCO, I_GMOE, I_WR, I_BR, I_WGU, I_BGU, I_WDN, I_BDN, I_GFINAL };

__global__ void __launch_bounds__(NWAVES * 64, 2) fwd(Args args) {
    extern __shared__ __attribute__((aligned(16))) unsigned char lds_raw[];
    LAS unsigned char* const lds = (LAS unsigned char*)lds_raw;
    const int G = gridDim.x, bx = blockIdx.x, vcu = (G % 8 == 0) ? (bx % 8) * (G / 8) + bx / 8 : bx;
    { const int t0 = threadIdx.x; for (int u = t0; u < (LDS_BYTES - MISC_OFF) / 4; u += NWAVES * 64) ((LAS unsigned*)(lds + MISC_OFF))[u] = 0u; }
    __syncthreads();
#ifndef PHASE_MASK
#define PHASE_MASK 0xFFF
#endif
    const int lo = args.ph_lo, hi = args.ph_hi;
    const bool IN2_ = ((PHASE_MASK >> 2) & 1) && lo <= 2 && 2 < hi;
    XcdBarrier bar; bar.bar = (unsigned*)(args.ws + WS_CTL) + CW_BAR + args.li * XCD_BAR_WORDS; bar.x = 0; bar.st = nullptr; bar.gexp = 0u;
    if (hi - lo > 1) bar = xcd_barrier_post((unsigned*)(args.ws + WS_CTL) + CW_BAR + args.li * XCD_BAR_WORDS, (volatile LAS unsigned*)(lds + MISC_OFF));
    const bool fuse23 = IN2_ && (G % 16 == 0);
    XcdBarrier bar2 = bar;
    if (fuse23 && (vcu & 1) == 0) bar2 = xcd_barrier_post((unsigned*)(args.ws + WS_CTL) + CW_BAR + 3 * XCD_BAR_WORDS, (volatile LAS unsigned*)(lds + MISC_OFF + 8), (unsigned)(G / 2));
#define IN(k) (((PHASE_MASK >> (k)) & 1) && lo <= (k) && (k) < hi)
#define SEAM(k) do { if (IN(k) && IN((k) + 1)) xcd_barrier(bar); } while (0)
#define SEAM2(k, k2) do { if (IN(k) && IN(k2)) xcd_barrier(bar); } while (0)
#ifndef REPEAT_PHASE
#define REPEAT_PHASE -1
#endif
#define REP(k) for (int rep_ = 0; rep_ < ((k) == REPEAT_PHASE ? 2 : 1); (void)(++rep_), __syncthreads())
#define WSP(T, off) ((T*)(wsb + (off)))
typedef const unsigned char __attribute__((address_space(4)))* kaptr_t;
#define PHASE_WS() kaptr_t kab = (kaptr_t)__builtin_amdgcn_kernarg_segment_ptr(); asm volatile("" : "+s"(kab)); \
        GAS unsigned char* wsg_ = *(GAS unsigned char* const __attribute__((address_space(4)))*)(kab + 256); asm volatile("" : "+s"(wsg_)); unsigned char* wsb = (unsigned char*)wsg_
#define INP(i) ((const float*)*(GAS const float* const __attribute__((address_space(4)))*)(kab + 8 * (i)))
#define OUTP() ((float*)*(GAS float* const __attribute__((address_space(4)))*)(kab + 248))
#define SUB_WS() do { asm volatile("" : "+s"(wsg_)); wsb = (unsigned char*)wsg_; } while (0)
#define TIDS() const int tid = opaque_tid(), lane = tid & 63, wave = __builtin_amdgcn_readfirstlane(tid >> 6), gw = vcu * NWAVES + wave, NGW = G * NWAVES; (void)lane; (void)gw; (void)NGW

    REP(0) if (IN(0)) { PHASE_WS();
#ifndef P0A_REP
#define P0A_REP 1
#endif
#ifndef P0B_REP
#define P0B_REP 1
#endif
        for (int r4 = 0; r4 < P0A_REP; ++r4)
        { TIDS();
          ssm_tables(vcu >> 2, vcu & 3, INP(I_LRE), INP(I_LIM), INP(I_LSTEP), INP(I_BRE), INP(I_BIM), INP(I_CRE), INP(I_CIM), INP(I_DSKIP),
                                   WSP(f16, WS_KT), WSP(f16, WS_MIN), WSP(f16, WS_MOUT), WSP(float, WS_L64), lds, tid); }
        for (int r4 = 0; r4 < P0B_REP; ++r4)
        {
            TIDS();
            LAS float* wf = (LAS float*)lds; const float* w_in = INP(I_WIN);
            for (int i = tid; i < DM * 8; i += NWAVES * 64) wf[i + (i >> 6) * 4] = w_in[(size_t)(i >> 3) * INC + 4 * AW + (i & 7)];
            __syncthreads();
            f16* XN = WSP(f16, WS_XN); float* FL = WSP(float, WS_FL);
            {   f32x4 nx[8]; const float* xin = INP(I_X);
#pragma unroll
                for (int j = 0; j < 4; ++j) { nx[2 * j] = *(const f32x4*)(xin + (size_t)gw * DM + 8 * (lane + 64 * j)); nx[2 * j + 1] = *(const f32x4*)(xin + (size_t)gw * DM + 8 * (lane + 64 * j) + 4); }
#pragma unroll 1
                for (int m = gw; m < M; m += NGW) {
                    f32x4 cx[8];
#pragma unroll
                    for (int q = 0; q < 8; ++q) cx[q] = nx[q];
                    const int mn = (m + NGW < M) ? m + NGW : m;
#pragma unroll
                    for (int j = 0; j < 4; ++j) { nx[2 * j] = *(const f32x4*)(xin + (size_t)mn * DM + 8 * (lane + 64 * j)); nx[2 * j + 1] = *(const f32x4*)(xin + (size_t)mn * DM + 8 * (lane + 64 * j) + 4); }
                    float sq = 0.f;
#pragma unroll
                    for (int j = 0; j < 4; ++j)
#pragma unroll
                        for (int i = 0; i < 4; ++i) sq += cx[2 * j][i] * cx[2 * j][i] + cx[2 * j + 1][i] * cx[2 * j + 1][i];
                    const float rs = 1.0f / sqrtf(wave_sum(sq) * (1.0f / DM) + EPS);
#pragma unroll
                    for (int j = 0; j < 4; ++j) { const f32x4 ga = *(const f32x4*)(INP(I_GMIX) + 8 * (lane + 64 * j)), gb = *(const f32x4*)(INP(I_GMIX) + 8 * (lane + 64 * j) + 4);
                        cx[2 * j] = cx[2 * j] * (ga * rs); cx[2 * j + 1] = cx[2 * j + 1] * (gb * rs);
                        *(f16x8*)(XN + (size_t)m * DM + 8 * (lane + 64 * j)) = pack8h(cx[2 * j], cx[2 * j + 1]); }
                    float fl[8] = {0.f, 0.f, 0.f, 0.f, 0.f, 0.f, 0.f, 0.f};
#pragma unroll
                    for (int j = 0; j < 4; ++j) {
#pragma unroll
                        for (int i = 0; i < 8; ++i) { const int k = 8 * (lane + 64 * j) + i; const f32x4 wa = *(const LAS f32x4*)(wf + k * 8 + (lane + 64 * j) * 4), wb = *(const LAS f32x4*)(wf + k * 8 + (lane + 64 * j) * 4 + 4);
                            const float xv = cx[2 * j + (i >> 2)][i & 3];
#pragma unroll
                            for (int h = 0; h < 4; ++h) { fl[h] += xv * wa[h]; fl[4 + h] += xv * wb[h]; } }
                        __builtin_amdgcn_sched_barrier(0); }
#pragma unroll
                    for (int h = 0; h < 8; ++h) fl[h] = wave_sum(fl[h]);
                    if (lane < 8) { float v = fl[0];
#pragma unroll
                        for (int h = 1; h < 8; ++h) v = (lane == h) ? fl[h] : v;
                        FL[(size_t)m * 8 + lane] = v + INP(I_BF)[lane]; }
                }
            }
            f16* MEMN = WSP(f16, WS_MEMN);
            for (int m = gw; m < BATCH * MEML; m += NGW) { float xn[32]; norm_row_f16(INP(I_MEM) + (size_t)m * DM, INP(I_GMEM), MEMN + (size_t)m * DM, lane, xn); }
            {
                const float* wq = INP(I_WCQ); const float* gc = INP(I_GCROSS); f16* WCQS = WSP(f16, WS_WCQ);
                for (int v = gw * 64 + lane; v < DM * DM / 8; v += NGW * 64) { const float sc = gc[v >> 8] * 0.04419417382415922f;
                    const f32x4 a = *(const f32x4*)(wq + (size_t)v * 8), b = *(const f32x4*)(wq + (size_t)v * 8 + 4);
                    *(f16x8*)(WCQS + (size_t)v * 8) = pack8h(a * sc, b * sc); } }
            f16* WRT = WSP(f16, WS_WR);
            for (int i = gw * 64 + lane; i < NE * DM; i += NGW * 64) { const int e = i / DM, k = i % DM; WRT[i] = (f16)INP(I_WR)[(size_t)k * NE + e]; }
            __syncthreads();
        }
        {
            TIDS();
            LAS float* scr = (LAS float*)(lds + wave * (64 * 65 * 4));
            constexpr int I_IN = 32 * 64, I_GL = 16 * 16, I_OU = 32 * 32, I_KV = 32 * 64, I_CO = 32 * 32;
            constexpr int NITEMS = I_IN + I_GL + I_OU + I_KV + I_CO;
            const RowId rid;
            for (int it = gw; it < NITEMS; it += NGW) {
                int r = it;
                if (r < I_IN) { transpose_item<false>(INP(I_WIN), INC, 64 * (r / 64), 64 * (r % 64), WSP(f16, WS_WIN), DM, rid, nullptr, 1.0f, scr, lane); continue; } r -= I_IN;
                if (r < I_GL) { transpose_item<false>(INP(I_WGLU), SSMW, 64 * (r / 16), 64 * (r % 16), WSP(f16, WS_WGLU), SSMW, rid, nullptr, 1.0f, scr, lane); continue; } r -= I_GL;
                if (r < I_OU) { const int kb = r / 32; const float* ksc = kb < 16 ? INP(I_GATT) : INP(I_GSSM) - AW;
                    transpose_item<false>(INP(I_WOUT), DM, 64 * kb, 64 * (r % 32), WSP(f16, WS_WOUT), DM, rid, ksc, 1.0f, scr, lane); continue; } r -= I_OU;
                if (r < I_KV) { transpose_item<false>(INP(I_WCKV), 2 * DM, 64 * (r / 64), 64 * (r % 64), WSP(f16, WS_WCKV), DM, rid, nullptr, 1.0f, scr, lane); continue; } r -= I_KV;
                transpose_item<false>(INP(I_WCO), DM, 64 * (r / 32), 64 * (r % 32), WSP(f16, WS_WCO), DM, rid, nullptr, 1.0f, scr, lane);
            }
        }
    }
    SEAM(0);
    REP(1) if (IN(1)) { PHASE_WS();
        if (vcu < BATCH * AH) { TIDS(); cumsum_unit(vcu, WSP(float, WS_FL), WSP(float, WS_CNEG), lds, tid); }
        pg8::DenseOrder S; S.init(WSP(f16, WS_XN), WSP(f16, WS_WIN), M, 4 * AW, DM, G, bx);
        epi::InProj E{WSP(f16, WS_U), WSP(f16, WS_Q), (size_t)(WS_K - WS_Q) / 2, (int*)(wsb + WS_CTL) + CW_KMAX};
        pg8::gemm_phase<epi::InProj, pg8::DenseOrder>(lds, DM * 2, S, E);
    }
    SEAM(1);
#ifndef P2A_REP
#define P2A_REP 1
#endif
#ifndef P2B_REP
#define P2B_REP 1
#endif
    REP(2) if (IN(2)) { PHASE_WS();
        if ((vcu & 1) == 0) {
            const int w = vcu >> 1;
#pragma unroll 1
            for (int q = 0; q < 2 * P2A_REP; ++q) { const int id = 2 * w + (q & 1);
                fox::item(id >> 4, id & 15, WSP(f16, WS_Q), WSP(f16, WS_K), WSP(f16, WS_V), WSP(f16, WS_MIX), WSP(float, WS_SSATT), WSP(float, WS_CNEG), (const float*)(wsb + WS_CTL) + CW_KMAX, (char*)lds_raw); }
            SUB_WS();
#pragma unroll 1
            for (int q = 0; q < 2 * P2B_REP; ++q) { const int id = (q & 1) == 0 ? w : 255 - w;
                ssm::unit((id >> 1) >> 6, (id >> 1) & 63, id & 1, WSP(f16, WS_U), WSP(f16, WS_KT), WSP(f16, WS_MIN), WSP(f16, WS_MOUT), WSP(float, WS_L64), WSP(f16, WS_G), lds); }
            SUB_WS();
            {
                pg8::DenseOrder S; S.init(WSP(f16, WS_MEMN), WSP(f16, WS_WCKV), BATCH * MEML, 2 * DM, DM, G, (w & 7) < 2 ? 2 * (w >> 3) + (w & 7) : (1 << 20));
                epi::PlainF16 E{WSP(f16, WS_KVC), 2 * DM};
                pg8::gemm_phase<epi::PlainF16, pg8::DenseOrder>(lds, DM * 2, S, E);
            }
            if (fuse23) {
                xcd_barrier(bar2);
                SUB_WS();
                const int c2 = (bx & 7) + 8 * ((bx >> 3) >> 1);
                {   pg8::DenseOrder S; S.init(WSP(f16, WS_G), WSP(f16, WS_WGLU), M, SSMW, SSMW, G / 2, c2);
                    epi::Glu E{WSP(f16, WS_G), INP(I_BGLU), WSP(f16, WS_MIX), WSP(float, WS_SSSSM)};
                    pg8::gemm_phase<epi::Glu, pg8::DenseOrder>(lds, SSMW * 2, S, E); }
                SUB_WS();
                {   epi::CrossPreOut EP{WSP(unsigned char, WS_WKT), WSP(unsigned char, WS_VWT)};
                    pg8::CrossPre<0> S0{WSP(f16, WS_KVC), WSP(f16, WS_WCQ), c2 < 64 ? c2 : -1};
                    pg8::gemm_phase<epi::CrossPreOut, pg8::CrossPre<0>>(lds, CD * 2, S0, EP);
                    pg8::CrossPre<1> S1{WSP(f16, WS_KVC), WSP(f16, WS_WCO), (c2 >= 64 && c2 < 128) ? c2 - 64 : -1};
                    pg8::gemm_phase<epi::CrossPreOut, pg8::CrossPre<1>>(lds, CD * 2, S1, EP); }
            }
        }
        SUB_WS();
        {
            TIDS();
            LAS float* scr = (LAS float*)(lds + wave * (128 * 33 * 4));
            constexpr int I_GU = NE * 16 * 128, I_DN = NE * 16 * 64, NI = I_GU + I_DN, CH = 8;
            const RowId rid; const RowGU rgu;
#ifndef P2C_REP
#define P2C_REP 1
#endif
#pragma unroll 1
            for (int r3 = 0; r3 < P2C_REP; ++r3) {
            unsigned* claim = (unsigned*)(wsb + WS_CTL) + CW_CLAIM + 64 * r3;
#define XI_LOAD(v, it) do { int r_ = (it); if (r_ < I_GU) { const int e = r_ / 2048, q = r_ % 2048; qitem_load(v, INP(I_WGU) + (size_t)e * DM * 2 * DFF, 2 * DFF, 128 * (q / 128), 32 * (q % 128), lane); } \
        else { r_ -= I_GU; const int e = r_ / 1024, q = r_ % 1024; qitem_load(v, INP(I_WDN) + (size_t)e * DFF * DM, DM, 128 * (q / 64), 32 * (q % 64), lane); } } while (0)
#define XI_STORE(v, it) do { int r_ = (it); if (r_ < I_GU) { const int e = r_ / 2048, q = r_ % 2048; qitem_store(v, 128 * (q / 128), 32 * (q % 128), WSP(unsigned char, WS_WGU) + (size_t)e * 2 * DFF * DM, DM, rgu, WQ_SCALE, scr, lane); } \
        else { r_ -= I_GU; const int e = r_ / 1024, q = r_ % 1024; qitem_store(v, 128 * (q / 64), 32 * (q % 64), WSP(unsigned char, WS_WDN) + (size_t)e * DM * DFF, DFF, rid, WQ_SCALE, scr, lane); } } while (0)
            volatile LAS int* cw = (volatile LAS int*)(lds + MISC_OFF + 32);
#define XI_NEXT(dst, par) do { if (tid == 0) cw[par] = (int)atomicAdd(claim, 1u) * CH; __syncthreads(); dst = cw[par] + wave; } while (0)
            int ia, ib;
            f32x4 va[16], vb[16];
            XI_NEXT(ia, 0); if (ia < NI) XI_LOAD(va, ia);
            while (ia < NI) {
                XI_NEXT(ib, 1); if (ib < NI) XI_LOAD(vb, ib);
                XI_STORE(va, ia); if (ib >= NI) break;
                XI_NEXT(ia, 0); if (ia < NI) XI_LOAD(va, ia);
                XI_STORE(vb, ib);
            }
            __syncthreads();
            }
#undef XI_LOAD
#undef XI_STORE
#undef XI_NEXT
        }
    }
    SEAM2(2, 4);
#ifndef EXTRA_BARS
#define EXTRA_BARS 0
#endif
    if (hi - lo > 1) for (int xb_ = 0; xb_ < EXTRA_BARS; ++xb_) xcd_barrier(bar);
    REP(4) if (IN(4)) { PHASE_WS();
        pg8::DenseOrder S; S.init(WSP(f16, WS_MIX), WSP(f16, WS_WOUT), M, DM, DM, G, bx);
        epi::OutProj E{INP(I_X), WSP(f16, WS_HA), WSP(float, WS_SSATT), WSP(float, WS_SSSSM), WSP(float, WS_SSH), WSP(unsigned char, WS_H8)};
        pg8::gemm_phase<epi::OutProj, pg8::DenseOrder, true>(lds, DM * 2, S, E, (LAS float*)(lds + MSC_OFF));
    }
    SEAM(4);
    REP(5) if (IN(5)) { PHASE_WS();
        pg8::DenseOrder S; S.init(WSP(f16, WS_H8), WSP(f16, WS_WKT), M, CH * MEML, DM / 2, G, bx, (size_t)CH * MEML * DM);
        epi::CrossSoftmax E{WSP(unsigned char, WS_PB), WSP(float, WS_SSH), (LAS float*)(lds + XCH_OFF)};
        pg8::gemm_phase<epi::CrossSoftmax, pg8::DenseOrder, false, true>(lds, DM, S, E);
    }
    SEAM(5);
    REP(7) if (IN(7)) { PHASE_WS();
        pg8::DenseOrder S; S.init(WSP(f16, WS_PB), WSP(f16, WS_VWT), M, DM, CH * MEML / 2, G, bx, (size_t)DM * CH * MEML);
        epi::CrossO E{WSP(f16, WS_HA), WSP(float, WS_SSH2)};
        pg8::gemm_phase<epi::CrossO, pg8::DenseOrder, false, true>(lds, CH * MEML, S, E);
    }
    SEAM(7);
    REP(8) if (IN(8)) { PHASE_WS();
        TIDS();
        LAS float* lg = (LAS float*)(lds + wave * (16 * 33 * 4));
#ifndef P8_REP
#define P8_REP 1
#endif
        for (int r5 = 0; r5 < P8_REP; ++r5)
        { const int t = (wave & 3) * G + vcu;
          router_task(t < M / 16 ? t : 0, wave >> 2, (LAS float*)(lds + NWAVES * 16 * 33 * 4) + (wave & 3) * 512, WSP(f16, WS_HA), WSP(float, WS_SSH2), INP(I_GMOE), WSP(f16, WS_WR), INP(I_BR), WSP(unsigned char, WS_X2N), WSP(RouteRec, WS_ROUTE), WSP(int, WS_ROWTOK),
                                                           (unsigned*)(wsb + WS_CTL) + CW_CNT, lg, lane, r5 == P8_REP - 1 && t < M / 16); }
    }
    SEAM(8);
    REP(9) if (IN(9)) { PHASE_WS();
        { TIDS(); moe_table((unsigned*)(wsb + WS_CTL) + CW_CNT, (LAS int*)(lds + MOE_TAB_OFF), tid); }
        MoeOrder<true> S{(LAS int*)(lds + MOE_TAB_OFF), (const char*)WSP(char, WS_X2N), (const char*)WSP(char, WS_WGU), WSP(int, WS_ROWTOK), (size_t)2 * DFF * DM, DM, 16, G, bx};
        epi::ExpertGU E{WSP(unsigned char, WS_ACT), INP(I_BGU)};
        pg8::gemm_phase<epi::ExpertGU, MoeOrder<true>, false, true>(lds, DM, S, E);
    }
    SEAM(9);
    REP(10) if (IN(10)) { PHASE_WS();
        { TIDS(); moe_table((unsigned*)(wsb + WS_CTL) + CW_CNT, (LAS int*)(lds + MOE_TAB_OFF), tid); }
        MoeOrder<false> S{(LAS int*)(lds + MOE_TAB_OFF), (const char*)WSP(char, WS_ACT), (const char*)WSP(char, WS_WDN), WSP(int, WS_ROWTOK), (size_t)DM * DFF, DFF, 8, G, bx};
        epi::ExpertDown E{WSP(unsigned char, WS_YS), INP(I_BDN)};
        pg8::gemm_phase<epi::ExpertDown, MoeOrder<false>, false, true>(lds, DFF, S, E);
    }
    SEAM(10);
    REP(11) if (IN(11)) { PHASE_WS();
        TIDS();
        moe_table((unsigned*)(wsb + WS_CTL) + CW_CNT, (LAS int*)(lds + MOE_TAB_OFF), tid);
        for (int m = gw; m < M; m += NGW) final_row(m, WSP(f16, WS_HA), WSP(unsigned char, WS_YS), WSP(RouteRec, WS_ROUTE), (const LAS int*)(lds + MOE_TAB_OFF), INP(I_GFINAL), OUTP(), lane);
    }
#undef IN
#undef SEAM
#undef REP
#undef WSP
#undef INP
#undef OUTP
#undef PHASE_WS
#undef SUB_WS
#undef TIDS
}

extern "C" void kernel_launch(void* const* d_in, const int* in_sizes, int n_in, void* d_out, int out_size, void* d_ws, size_t ws_size, hipStream_t stream) {
    static int grid = 0;
    if (grid == 0) {
        if (n_in != 31 || in_sizes[0] != M * DM || out_size != M * DM || ws_size < WS_END) {
            fprintf(stderr, "kernel_launch: built for 31 inputs, x/out of %d floats, >= %zu bytes of workspace; got n_in %d, in0 %d, out %d, ws %zu; nothing launched\n", M * DM, (size_t)WS_END, n_in, n_in > 0 ? in_sizes[0] : -1, out_size, ws_size);
            grid = -1; return; }
        int dev = 0, cus = 0, per_cu = 0;
        if (hipGetDevice(&dev) != hipSuccess || hipDeviceGetAttribute(&cus, hipDeviceAttributeMultiprocessorCount, dev) != hipSuccess) { fprintf(stderr, "kernel_launch: device query failed\n"); grid = -1; return; }
        if (hipFuncSetAttribute((const void*)fwd, hipFuncAttributeMaxDynamicSharedMemorySize, LDS_BYTES) != hipSuccess) { fprintf(stderr, "kernel_launch: hipFuncSetAttribute failed\n"); grid = -1; return; }
        if (hipOccupancyMaxActiveBlocksPerMultiprocessor(&per_cu, (const void*)fwd, NWAVES * 64, LDS_BYTES) != hipSuccess || per_cu < 1)
            fprintf(stderr, "kernel_launch: note: occupancy query reports %d workgroups per CU\n", per_cu);
        (void)hipGetLastError();
        grid = (cus / 16) * 16;
        if (grid != 256) fprintf(stderr, "kernel_launch: %d CUs; the phase program assumes 256\n", grid);
    }
    if (grid < 0) return;
    if (hipMemsetAsync((char*)d_ws + WS_CTL, 0, CTL_ZERO_BYTES, stream) != hipSuccess) { fprintf(stderr, "kernel_launch: memset failed\n"); return; }
    Args a{};
    for (int i = 0; i < 31; ++i) a.in[i] = (const float*)d_in[i];
    a.out = (float*)d_out; a.ws = (unsigned char*)d_ws;
    constexpr int NL = MK_N_LAUNCHES;
    for (int li = 0; li < NL; ++li) {
        a.ph_lo = (NL == 1) ? 0 : li; a.ph_hi = (NL == 1) ? N_PHASES : li + 1; a.li = 0; a.pad = 0;
        hipLaunchKernelGGL(fwd, dim3(grid), dim3(NWAVES * 64), LDS_BYTES, stream, a);
        const hipError_t le = hipPeekAtLastError();
        if (le != hipSuccess) { fprintf(stderr, "kernel_launch: launch %d failed: %s\n", li, hipGetErrorName(le)); break; }
    }
}
```

```cpp
#include <hip/hip_runtime.h>
#include <cstdio>
#include <cstdint>

#define GAS __attribute__((address_space(1)))
#define LAS __attribute__((address_space(3)))
typedef _Float16 f16;
typedef _Float16 f16x2 __attribute__((ext_vector_type(2)));
typedef _Float16 f16x4 __attribute__((ext_vector_type(4)));
typedef _Float16 f16x8 __attribute__((ext_vector_type(8)));
typedef float f32x2 __attribute__((ext_vector_type(2)));
typedef float f32x4 __attribute__((ext_vector_type(4)));
typedef float f32x16 __attribute__((ext_vector_type(16)));
typedef unsigned u32x2 __attribute__((ext_vector_type(2)));
typedef unsigned u32x4 __attribute__((ext_vector_type(4)));
typedef GAS unsigned gu32;
#define RLX_AGENT __ATOMIC_RELAXED, __HIP_MEMORY_SCOPE_AGENT
#define LDS_WAIT() asm volatile("s_waitcnt lgkmcnt(0)" ::: "memory")
#define VM_WAIT() asm volatile("s_waitcnt vmcnt(0)" ::: "memory")

constexpr int BATCH = 2, SEQ = 8192, DM = 2048, M = BATCH * SEQ;
constexpr int SSMW = 1024, SG = 16, NG = 64, SP = 64;
constexpr int AW = 1024, AH = 8, AD = 128;
constexpr int INC = SSMW + 3 * AW + AH;
constexpr int MEML = 256, CH = 4, CD = 512;
constexpr int NE = 32, TOPK = 4, DFF = 2048;
constexpr float EPS = 1e-5f;
constexpr int CT = 64, NCH = SEQ / CT;

__device__ __forceinline__ unsigned pk2h(float lo, float hi) { f32x2 v = {lo, hi}; f16x2 h = __builtin_convertvector(v, f16x2); return __builtin_bit_cast(unsigned, h); }
__device__ __forceinline__ u32x2 pack8q(f32x4 a, f32x4 b) { unsigned w0 = 0, w1 = 0;
    w0 = __builtin_amdgcn_cvt_pk_fp8_f32(a[0], a[1], w0, false); w0 = __builtin_amdgcn_cvt_pk_fp8_f32(a[2], a[3], w0, true);
    w1 = __builtin_amdgcn_cvt_pk_fp8_f32(b[0], b[1], w1, false); w1 = __builtin_amdgcn_cvt_pk_fp8_f32(b[2], b[3], w1, true); return (u32x2){w0, w1}; }
constexpr float XH_SCALE = 16.0f, XK_SCALE = 256.0f, XP_SCALE = 256.0f, XV_SCALE = 16.0f;
constexpr int KM_STRIDE = 32;
constexpr float WQ_SCALE = 32.0f, WQ_INV = 1.0f / 32.0f;
__device__ __forceinline__ f16x8 pack8h(f32x4 a, f32x4 b) { u32x4 w = {pk2h(a[0], a[1]), pk2h(a[2], a[3]), pk2h(b[0], b[1]), pk2h(b[2], b[3])}; return __builtin_bit_cast(f16x8, w); }
__device__ __forceinline__ int opaque_tid() { int t = threadIdx.x; asm volatile("" : "+v"(t)); return t; }
__device__ __forceinline__ const char* uptr(const char* p) {
    const unsigned long long v = (unsigned long long)p; const unsigned lo = __builtin_amdgcn_readfirstlane((unsigned)v), hi = __builtin_amdgcn_readfirstlane((unsigned)(v >> 32));
    return (const char*)(((unsigned long long)hi << 32) | lo); }
__device__ __forceinline__ float wave_sum(float v) {
#pragma unroll
    for (int o = 1; o < 64; o <<= 1) v += __shfl_xor(v, o);
    return v;
}

#define XB_TMO      128
#define XB_XCNT(j)  (256  + 64 * (j))
#define XB_XSUB(j)  (1280 + 64 * (j))
#define XB_XGEN(j)  (2304 + 64 * (j))
#define XB_TOP      3328
#define XB_TOPGEN   3392
#define XCD_BAR_WORDS 3456
#define XB_SPIN_CAP (1u << 18)
__device__ __forceinline__ unsigned xb_ld(unsigned* p)              { return __hip_atomic_load(p, __ATOMIC_RELAXED, __HIP_MEMORY_SCOPE_AGENT); }
__device__ __forceinline__ unsigned xb_add(unsigned* p, unsigned v) { return __hip_atomic_fetch_add(p, v, __ATOMIC_RELAXED, __HIP_MEMORY_SCOPE_AGENT); }
__device__ __forceinline__ unsigned xb_xcc_id() { return (unsigned)__builtin_amdgcn_s_getreg((3 << 11) | 20) & 0xFu; }
#define XB_SPIN(cond, bar) do { unsigned _sp = 0; while (cond) { __builtin_amdgcn_s_sleep(1); \
    if ((++_sp & 255u) == 0u) { if (xb_ld(&(bar)[XB_TMO])) break; if (_sp > XB_SPIN_CAP) { atomicAdd(&(bar)[XB_TMO], 1u); break; } } } } while (0)
struct XcdBarrier { unsigned* bar; unsigned x; volatile LAS unsigned* st; unsigned gexp; };
__device__ __forceinline__ XcdBarrier xcd_barrier_post(unsigned* bar, volatile LAS unsigned* st, unsigned gexp = 0u) {
    XcdBarrier b; b.bar = bar; b.x = xb_xcc_id(); b.st = st; b.gexp = gexp;
    if (threadIdx.x == 0) (void)xb_add(&bar[XB_XCNT(b.x)], 1u);
    return b;
}
__device__ __forceinline__ void xcd_barrier_complete(unsigned* bar, unsigned x, unsigned& nloc, unsigned& nx, unsigned gexp) {
    const unsigned G = gexp ? gexp : gridDim.x * gridDim.y * gridDim.z;
    unsigned sum, cnt, mine, sp = 0u;
    for (;;) {
        sum = 0u; cnt = 0u; mine = 0u;
#pragma unroll
        for (unsigned j = 0; j < 16; ++j) { const unsigned c = xb_ld(&bar[XB_XCNT(j)]); sum += c; cnt += (c > 0u) ? 1u : 0u; mine = (j == x) ? c : mine; }
        if (sum == G) break;
        __builtin_amdgcn_s_sleep(1);
        if ((++sp & 255u) == 0u) { if (xb_ld(&bar[XB_TMO])) break; if (sp > XB_SPIN_CAP) { atomicAdd(&bar[XB_TMO], 1u); break; } }
    }
    nloc = mine > 0u ? mine : 1u; nx = cnt > 0u ? cnt : 1u;
}
__device__ __forceinline__ void xcd_barrier(const XcdBarrier& b) {
    asm volatile("s_waitcnt vmcnt(0)" ::: "memory");
    __syncthreads();
    if (threadIdx.x == 0) {
        unsigned* bar = b.bar;
        __builtin_amdgcn_s_waitcnt(0);
        unsigned nloc = b.st[0], nx = b.st[1];
        if (nloc == 0u) { xcd_barrier_complete(bar, b.x, nloc, nx, b.gexp); b.st[0] = nloc; b.st[1] = nx; }
        const unsigned old = xb_add(&bar[XB_XSUB(b.x)], 1u);
        const unsigned gen = old / nloc;
        if (old + 1u == (gen + 1u) * nloc) {
            __builtin_amdgcn_fence(__ATOMIC_RELEASE, "agent");
            asm volatile("s_waitcnt vmcnt(0)" ::: "memory");
            const unsigned og = xb_add(&bar[XB_TOP], 1u);
            const unsigned tg = og / nx;
            if (og + 1u == (tg + 1u) * nx) xb_add(&bar[XB_TOPGEN], 1u);
            else XB_SPIN(xb_ld(&bar[XB_TOPGEN]) == tg, bar);
            __builtin_amdgcn_fence(__ATOMIC_ACQUIRE, "agent");
            xb_add(&bar[XB_XGEN(b.x)], 1u);
            asm volatile("s_waitcnt vmcnt(0)" ::: "memory");
        } else {
            XB_SPIN(xb_ld(&bar[XB_XGEN(b.x)]) == gen, bar);
            __builtin_amdgcn_fence(__ATOMIC_ACQUIRE, "agent");
            asm volatile("s_waitcnt vmcnt(0)" ::: "memory");
        }
    }
    __syncthreads();
}

namespace pg8 {
constexpr int BM = 256, BK = 64, HALF = 128, HTB = HALF * BK * 2, STAGE_BYTES = 8 * HTB, NXCD = 8, WGM = 8;
__host__ __device__ __forceinline__ int lds_byte(int r, int c) { const int st = (r >> 4) * 2 + (c >> 5), rr = r & 15, cc = c & 31, ob = rr * 64 + cc * 2; return st * 1024 + (ob ^ (((ob >> 9) & 1) << 5)); }
__host__ __device__ __forceinline__ void stage_rc(int b, int& R, int& C) { const int st = b / 1024, sb = b % 1024, swz = sb ^ (((sb >> 9) & 1) << 5); R = (st >> 1) * 16 + swz / 64; C = (st & 1) * 32 + (swz % 64) / 2; }
__host__ __device__ __forceinline__ int perm32(int rho) { const int n = rho >> 4, i = rho & 15; return 8 * (i >> 2) + 4 * n + (i & 3); }

struct Unit { int pm, pn, aux; };

struct DenseOrder {
    static constexpr bool GATHER = false;
    const f16* A; const f16* Bt; int K; int nM, nN, nwg, G, c; size_t bstride;
    __device__ void init(const f16* A_, const f16* Bt_, int M_, int N_, int K_, int G_, int c_, size_t bstride_ = 0) { A = A_; Bt = Bt_; K = K_; nM = M_ / BM; nN = N_ / BM; nwg = nM * nN; G = G_; c = c_; bstride = bstride_; }
    __device__ bool next(int i, Unit& u) const {
        const long L = (long)i * G + c; if (L >= nwg) return false;
        int wgid = (int)L; { const int q = nwg / NXCD, r = nwg % NXCD, xcd = wgid % NXCD, off = wgid / NXCD; wgid = (xcd < r ? xcd * (q + 1) : r * (q + 1) + (xcd - r) * q) + off; }
        const int nig = WGM * nN, gid = wgid / nig, fm = gid * WGM, gsz = (nM - fm) < WGM ? (nM - fm) : WGM;
        u.pm = fm + ((wgid % nig) % gsz); u.pn = (wgid % nig) / gsz; u.aux = 0; return true;
    }
    __device__ __forceinline__ int pitch_a() const { return K * 2; }
    __device__ __forceinline__ int pitch_b() const { return K * 2; }
    __device__ __forceinline__ const char* a_ptr(const Unit& u) const { return (const char*)A + (size_t)u.pm * BM * K * 2; }
    __device__ __forceinline__ const char* b_ptr(const Unit& u) const { return (const char*)Bt + (size_t)(u.pm >> 5) * bstride + (size_t)u.pn * BM * K * 2; }
    __device__ __forceinline__ unsigned a_row(const Unit&, int r) const { return (unsigned)r; }
};
template <int TYPE>
struct CrossPre {
    static constexpr bool GATHER = false;
    const f16* KVC; const f16* W; int c;
    __device__ bool next(int i, Unit& u) const { if (i > 0 || c < 0 || c >= 64) return false; u.pm = c >> 3; u.pn = c & 7; u.aux = TYPE; return true; }
    __device__ __forceinline__ int pitch_a() const { return TYPE == 0 ? 2 * DM * 2 : DM * 2; }
    __device__ __forceinline__ int pitch_b() const { return TYPE == 0 ? DM * 2 : 2 * DM * 2; }
    __device__ __forceinline__ const char* kv(const Unit& u) const { return (const char*)(KVC + (size_t)((u.pm >> 2) * MEML) * (2 * DM) + (TYPE == 0 ? 0 : DM) + (u.pm & 3) * CD); }
    __device__ __forceinline__ const char* w(const Unit& u) const { return (const char*)(W + (size_t)(u.pn * 256) * DM + (u.pm & 3) * CD); }
    __device__ __forceinline__ const char* a_ptr(const Unit& u) const { return TYPE == 0 ? kv(u) : w(u); }
    __device__ __forceinline__ const char* b_ptr(const Unit& u) const { return TYPE == 0 ? w(u) : kv(u); }
    __device__ __forceinline__ unsigned a_row(const Unit&, int r) const { return (unsigned)r; }
};
typedef int i32x4 __attribute__((ext_vector_type(4)));
typedef int i32x8 __attribute__((ext_vector_type(8)));
template <class Epi, class Sched, bool MIDSCALE = false, bool FP8 = false, bool SP2 = true>
__device__ __forceinline__ void gemm_phase(LAS unsigned char* lds, const int KB, const Sched& S, const Epi& E, LAS float* msl = nullptr) {
    const int tid = opaque_tid(), wid = __builtin_amdgcn_readfirstlane(tid >> 6), lane = tid & 63, wr = wid >> 2, wc = wid & 3, fr = lane & 15, fq = lane >> 4;
    const int nt = KB / 128, pitchA = S.pitch_a(), pitchB = S.pitch_b();
    int sR[2], sC[2]; unsigned voffB[2];
#pragma unroll
    for (int i = 0; i < 2; ++i) { int R, C; stage_rc(tid * 16 + i * 8192, R, C); const int Rb = Epi::PERM ? ((R & ~31) + perm32(R & 31)) : R; sR[i] = R; sC[i] = C; voffB[i] = (unsigned)(Rb * pitchB + C * 2); }
    const size_t kstep = (size_t)(BK * 2);
    const size_t hstepB = (size_t)HALF * pitchB;
    const unsigned ldsw = (unsigned)wid * 1024u;
    const int aoff = lds_byte(wr * 64 + fr, fq * 8), boff = lds_byte(wc * 32 + fr, fq * 8);
#define PG8_SA(b, h) (((b) * 2 + (h)) * HTB)
#define PG8_SB(b, h) ((4 + (b) * 2 + (h)) * HTB)
#define PG8_STAGE2(bufoff, gbase, o0, o1) do { \
        __builtin_amdgcn_global_load_lds((const unsigned*)((const char*)(gbase) + (o0)), (LAS unsigned*)(lds + (bufoff) + ldsw), 16, 0, 0); \
        __builtin_amdgcn_global_load_lds((const unsigned*)((const char*)(gbase) + (o1)), (LAS unsigned*)(lds + (bufoff) + ldsw + 8192), 16, 0, 0); } while (0)
#define PG8_STAGE(bufoff, gbase, voff) PG8_STAGE2(bufoff, gbase, (voff)[0], (voff)[1])
#define PG8_SEL(h, i) ((Sched::GATHER && last) ? vN[h][i] : vA[h][i])
#define PG8_LD8(p) __builtin_shufflevector(*(const LAS i32x4*)(p), *(const LAS i32x4*)((p) + 1024), 0, 1, 2, 3, 4, 5, 6, 7)
#define PG8_LDA(dst, b, h) do { _Pragma("unroll") for (int m = 0; m < 4; ++m) dst[m] = PG8_LD8(lds + PG8_SA(b, h) + aoff + m * 2048); } while (0)
#define PG8_LDB(dst, b, h) do { _Pragma("unroll") for (int n = 0; n < 2; ++n) dst[n] = PG8_LD8(lds + PG8_SB(b, h) + boff + n * 2048); } while (0)
#define PG8_H0(x) __builtin_bit_cast(f16x8, __builtin_shufflevector(x, x, 0, 1, 2, 3))
#define PG8_H1(x) __builtin_bit_cast(f16x8, __builtin_shufflevector(x, x, 4, 5, 6, 7))
#define PG8_MMA(ai, bj, At, Bt) do { __builtin_amdgcn_s_setprio(1); \
        if constexpr (FP8) { _Pragma("unroll") for (int m = 0; m < 4; ++m) _Pragma("unroll") for (int n = 0; n < 2; ++n) \
            asm volatile("v_mfma_f32_16x16x128_f8f6f4 %0, %1, %2, %0" : "+v"(acc[ai][bj][m][n]) : "v"(Bt[n]), "v"(At[m])); } \
        else { _Pragma("unroll") for (int m = 0; m < 4; ++m) _Pragma("unroll") for (int n = 0; n < 2; ++n) { \
            acc[ai][bj][m][n] = __builtin_amdgcn_mfma_f32_16x16x32_f16(PG8_H0(Bt[n]), PG8_H0(At[m]), acc[ai][bj][m][n], 0, 0, 0); \
            acc[ai][bj][m][n] = __builtin_amdgcn_mfma_f32_16x16x32_f16(PG8_H1(Bt[n]), PG8_H1(At[m]), acc[ai][bj][m][n], 0, 0, 0); } } \
        __builtin_amdgcn_s_setprio(0); } while (0)
#define PG8_WAIT_V(n) asm volatile("s_waitcnt vmcnt(" #n ")" ::: "memory")
#define PG8_WAIT_L(n) asm volatile("s_waitcnt lgkmcnt(" #n ")" ::: "memory")
#define PG8_BAR __builtin_amdgcn_s_barrier()
#define PG8_SCHED __builtin_amdgcn_sched_barrier(0)
#define PG8_VOFFA(dst, u) do { _Pragma("unroll") for (int _h = 0; _h < 2; ++_h) _Pragma("unroll") for (int _i = 0; _i < 2; ++_i) dst[_h][_i] = S.a_row(u, _h * HALF + sR[_i]) * (unsigned)pitchA + (unsigned)sC[_i] * 2u; } while (0)
    Unit cur, nxt; int ui = 0;
    if (!S.next(0, cur)) return;
    f32x4 acc[2][2][4][2];
#pragma unroll
    for (int a = 0; a < 2; ++a)
#pragma unroll
        for (int b = 0; b < 2; ++b)
#pragma unroll
            for (int m = 0; m < 4; ++m)
#pragma unroll
                for (int n = 0; n < 2; ++n) acc[a][b][m][n] = (f32x4){0.f, 0.f, 0.f, 0.f};
    const int one_scale = 0x7F7F7F7F;
    (void)one_scale;
    i32x8 At[4], B0[2], B1[2];
    unsigned vA[2][2], vN[2][2];
    const char* cA = S.a_ptr(cur); const char* cB = S.b_ptr(cur);
    PG8_VOFFA(vA, cur);
    if constexpr (SP2) {
        PG8_STAGE(PG8_SB(0, 0), cB, voffB); PG8_STAGE(PG8_SB(0, 1), cB + hstepB, voffB); PG8_STAGE(PG8_SA(0, 0), cA, vA[0]); PG8_STAGE(PG8_SA(0, 1), cA, vA[1]);
        if (wr == 1) PG8_BAR;
        PG8_WAIT_V(2); PG8_BAR;
        PG8_STAGE(PG8_SB(1, 0), cB + kstep, voffB); PG8_STAGE(PG8_SA(1, 0), cA + kstep, vA[0]); PG8_STAGE(PG8_SB(1, 1), cB + hstepB + kstep, voffB);
        PG8_WAIT_V(6); PG8_BAR;
    } else {
    PG8_STAGE(PG8_SB(0, 0), cB, voffB); PG8_STAGE(PG8_SA(0, 0), cA, vA[0]); PG8_STAGE(PG8_SB(0, 1), cB + hstepB, voffB); PG8_STAGE(PG8_SA(0, 1), cA, vA[1]);
    if (wr == 1) PG8_BAR;
    PG8_WAIT_V(4); PG8_BAR;
    PG8_STAGE(PG8_SB(1, 0), cB + kstep, voffB); PG8_STAGE(PG8_SA(1, 0), cA + kstep, vA[0]); PG8_STAGE(PG8_SB(1, 1), cB + hstepB + kstep, voffB);
    PG8_WAIT_V(6); PG8_BAR;
    }
    for (;;) {
        const bool has_next = S.next(ui + 1, nxt);
        const char* nA = has_next ? S.a_ptr(nxt) : cA + 2 * kstep; const char* nB = has_next ? S.b_ptr(nxt) : cB + 2 * kstep;
        if constexpr (MIDSCALE) E.midscale_store(msl, cur, tid);
#ifndef KLOOP_REP
#define KLOOP_REP 1
#endif
#ifndef KLOOP_FP8
#define KLOOP_FP8 true
#endif
        for (int kp_ = 0; kp_ < ((FP8 == KLOOP_FP8) ? KLOOP_REP : 1); ++kp_) {
        const bool lastpass = (kp_ == ((FP8 == KLOOP_FP8) ? KLOOP_REP : 1) - 1);
        if (kp_ > 0) {
#pragma unroll
            for (int a = 0; a < 2; ++a)
#pragma unroll
                for (int b = 0; b < 2; ++b)
#pragma unroll
                    for (int m = 0; m < 4; ++m)
#pragma unroll
                        for (int n = 0; n < 2; ++n) acc[a][b][m][n] = (f32x4){0.f, 0.f, 0.f, 0.f}; }
        for (int t = 0; t < nt; t += 2) {
            const bool last = (t == nt - 2);
            const char* a1 = uptr(cA + (size_t)(t + 1) * kstep);
            const char* a2 = uptr(last ? (lastpass ? nA : cA) : cA + (size_t)(t + 2) * kstep); const char* b2 = uptr(last ? (lastpass ? nB : cB) : cB + (size_t)(t + 2) * kstep);
            const char* a3 = a2 + kstep; const char* b3 = b2 + kstep;
            if constexpr (Sched::GATHER) {
                if (t == nt - 4) { if (has_next && lastpass) { PG8_VOFFA(vN, nxt); } else {
#pragma unroll
                    for (int _h = 0; _h < 2; ++_h)
#pragma unroll
                        for (int _i = 0; _i < 2; ++_i) vN[_h][_i] = vA[_h][_i]; } } }
            if constexpr (MIDSCALE) { if (t == nt / 2) {
#pragma unroll
                for (int a = 0; a < 2; ++a)
#pragma unroll
                    for (int m = 0; m < 4; ++m) { const float sc_ = msl[a * HALF + wr * 64 + m * 16 + fr];
#pragma unroll
                        for (int b = 0; b < 2; ++b)
#pragma unroll
                            for (int n = 0; n < 2; ++n) acc[a][b][m][n] = acc[a][b][m][n] * sc_; }
                PG8_SCHED; } }
            if constexpr (SP2) {
            PG8_LDB(B0, 0, 0); PG8_LDB(B1, 0, 1); PG8_SCHED; PG8_LDA(At, 0, 0); PG8_STAGE(PG8_SA(1, 1), a1, vA[1]);
            PG8_WAIT_V(8); PG8_WAIT_L(0); PG8_BAR; PG8_MMA(0, 0, At, B0); PG8_MMA(0, 1, At, B1); PG8_BAR; PG8_SCHED;
            PG8_LDA(At, 0, 1); PG8_STAGE(PG8_SB(0, 0), b2, voffB); PG8_STAGE(PG8_SB(0, 1), b2 + hstepB, voffB); PG8_STAGE2(PG8_SA(0, 0), a2, PG8_SEL(0, 0), PG8_SEL(0, 1));
            PG8_WAIT_V(8); PG8_WAIT_L(0); PG8_BAR; PG8_MMA(1, 0, At, B0); PG8_MMA(1, 1, At, B1); PG8_BAR; PG8_SCHED;
            PG8_LDB(B0, 1, 0); PG8_LDB(B1, 1, 1); PG8_SCHED; PG8_LDA(At, 1, 0); PG8_STAGE2(PG8_SA(0, 1), a2, PG8_SEL(1, 0), PG8_SEL(1, 1));
            PG8_WAIT_V(8); PG8_WAIT_L(0); PG8_BAR; PG8_MMA(0, 0, At, B0); PG8_MMA(0, 1, At, B1); PG8_BAR; PG8_SCHED;
            PG8_LDA(At, 1, 1); PG8_STAGE(PG8_SB(1, 0), b3, voffB); PG8_STAGE(PG8_SB(1, 1), b3 + hstepB, voffB); PG8_STAGE2(PG8_SA(1, 0), a3, PG8_SEL(0, 0), PG8_SEL(0, 1));
            PG8_WAIT_V(8); PG8_WAIT_L(0); PG8_BAR; PG8_MMA(1, 0, At, B0); PG8_MMA(1, 1, At, B1); PG8_BAR; PG8_SCHED;
            } else {
            PG8_LDB(B0, 0, 0); PG8_SCHED; PG8_LDA(At, 0, 0); PG8_STAGE(PG8_SA(1, 1), a1, vA[1]);
            PG8_WAIT_L(8); PG8_BAR; PG8_WAIT_L(0); PG8_MMA(0, 0, At, B0); PG8_BAR; PG8_SCHED;
            PG8_LDB(B1, 0, 1); PG8_STAGE(PG8_SB(0, 0), b2, voffB);
            PG8_BAR; PG8_WAIT_L(0); PG8_MMA(0, 1, At, B1); PG8_BAR;
            PG8_LDA(At, 0, 1); PG8_STAGE2(PG8_SA(0, 0), a2, PG8_SEL(0, 0), PG8_SEL(0, 1));
            PG8_BAR; PG8_WAIT_L(0); PG8_MMA(1, 0, At, B0); PG8_BAR; PG8_SCHED;
            PG8_STAGE(PG8_SB(0, 1), b2 + hstepB, voffB);
            PG8_WAIT_V(6); PG8_BAR; PG8_MMA(1, 1, At, B1); PG8_BAR;
            PG8_LDB(B0, 1, 0); PG8_SCHED; PG8_LDA(At, 1, 0); PG8_STAGE2(PG8_SA(0, 1), a2, PG8_SEL(1, 0), PG8_SEL(1, 1));
            PG8_WAIT_L(8); PG8_BAR; PG8_WAIT_L(0); PG8_MMA(0, 0, At, B0); PG8_BAR; PG8_SCHED;
            PG8_LDB(B1, 1, 1); PG8_STAGE(PG8_SB(1, 0), b3, voffB);
            PG8_BAR; PG8_WAIT_L(0); PG8_MMA(0, 1, At, B1); PG8_BAR;
            PG8_LDA(At, 1, 1); PG8_STAGE2(PG8_SA(1, 0), a3, PG8_SEL(0, 0), PG8_SEL(0, 1));
            PG8_BAR; PG8_WAIT_L(0); PG8_MMA(1, 0, At, B0); PG8_BAR; PG8_SCHED;
            PG8_STAGE(PG8_SB(1, 1), b3 + hstepB, voffB);
            PG8_WAIT_V(6); PG8_BAR; PG8_MMA(1, 1, At, B1); PG8_BAR;
                    }
        }
        }
        if (wr == 0) PG8_BAR;
        if constexpr (FP8) asm volatile("s_nop 15\n\ts_nop 15" ::: "memory");
#ifndef EPI_REP
#define EPI_REP 1
#endif
        for (int er_ = 0; er_ < (FP8 ? EPI_REP : 1); ++er_)
        E(acc, cur, wr, wc, fr, fq);
        if (!has_next) break;
#pragma unroll
        for (int a = 0; a < 2; ++a)
#pragma unroll
            for (int b = 0; b < 2; ++b)
#pragma unroll
                for (int m = 0; m < 4; ++m)
#pragma unroll
                    for (int n = 0; n < 2; ++n) acc[a][b][m][n] = (f32x4){0.f, 0.f, 0.f, 0.f};
        cur = nxt; cA = nA; cB = nB; ++ui;
        if (wr == 1) PG8_BAR;
        if constexpr (Sched::GATHER) {
#pragma unroll
            for (int _h = 0; _h < 2; ++_h)
#pragma unroll
                for (int _i = 0; _i < 2; ++_i) vA[_h][_i] = vN[_h][_i]; }
    }
    PG8_WAIT_V(0);
    PG8_BAR;
#undef PG8_SA
#undef PG8_SB
#undef PG8_STAGE
#undef PG8_STAGE2
#undef PG8_SEL
#undef PG8_LDA
#undef PG8_LDB
#undef PG8_MMA
#undef PG8_H0
#undef PG8_H1
#undef PG8_LD8
#undef PG8_WAIT_V
#undef PG8_WAIT_L
#undef PG8_BAR
#undef PG8_SCHED
#undef PG8_VOFFA
}
}

namespace epi {
using pg8::Unit;
typedef f32x4 Acc[2][2][4][2];
__device__ __forceinline__ float rstd_of(float ss, float inv_n) { return __builtin_amdgcn_rsqf(ss * inv_n + EPS); }
__device__ __forceinline__ float quad_sum(float s) { s += __shfl_xor(s, 16); s += __shfl_xor(s, 32); return s; }
template <int NP> __device__ __forceinline__ float ss_full(const float* p) {
    float s = 0.f;
#pragma unroll
    for (int i = 0; i < NP / 4; ++i) { const f32x4 v = *(const f32x4*)(p + 4 * i); s += (v[0] + v[1]) + (v[2] + v[3]); }
    return s;
}
template <int NP> __device__ __forceinline__ float ss_quad(const float* p, int fq) {
    return quad_sum(ss_full<NP / 4>(p + fq * (NP / 4)));
}

struct InProj {
    static constexpr bool PERM = true;
    f16* U; f16* QKV; size_t stride; int* kmax;
    __device__ __forceinline__ void operator()(const Acc& acc, const Unit& u, int wr, int wc, int fr, int fq) const {
        const int row0 = u.pm * 256 + wr * 64 + fr, colt = u.pn * 256, seg = colt >> 10, cl = colt & 1023;
        f16* base = QKV + (size_t)(seg > 0 ? seg - 1 : 0) * stride;
        float km[2] = {0.f, 0.f};
#pragma unroll
        for (int ai = 0; ai < 2; ++ai)
#pragma unroll
            for (int m = 0; m < 4; ++m) { const int row = row0 + ai * 128 + m * 16, b = row >> 13, t = row & (SEQ - 1);
#pragma unroll
                for (int bj = 0; bj < 2; ++bj) { const int col = cl + bj * 128 + wc * 32 + 8 * fq;
                    const f32x4 a0 = acc[ai][bj][m][0], a1 = acc[ai][bj][m][1];
                    const f16x8 w = pack8h(a0, a1);
                    f16* dst = (seg == 0) ? U + (((size_t)(b * NG + (col >> 4)) * SEQ + t) * SG + (col & 15)) : base + (size_t)row * 1024 + col;
                    *(f16x8*)dst = w;
                    if (seg == 2) { float sq = (a0[0] * a0[0] + a0[1] * a0[1]) + (a0[2] * a0[2] + a0[3] * a0[3]) + (a1[0] * a1[0] + a1[1] * a1[1]) + (a1[2] * a1[2] + a1[3] * a1[3]);
                        sq = quad_sum(sq); km[bj] = fmaxf(km[bj], sq); } } }
        if (seg == 2) {
#pragma unroll
            for (int bj = 0; bj < 2; ++bj) { float v = km[bj];
                v = fmaxf(v, __shfl_xor(v, 1)); v = fmaxf(v, __shfl_xor(v, 2)); v = fmaxf(v, __shfl_xor(v, 4)); v = fmaxf(v, __shfl_xor(v, 8));
                if (fr == 0 && fq == 0) { const int b = (u.pm * 256) >> 13, head = (cl >> 7) + bj; atomicMax(kmax + ((b * AH + head) * 4 + wc) * KM_STRIDE, __float_as_int(v)); } }
        }
    }
};
struct PlainF16 {
    static constexpr bool PERM = true;
    f16* O; int ldc;
    __device__ __forceinline__ void operator()(const Acc& acc, const Unit& u, int wr, int wc, int fr, int fq) const {
        const int row0 = u.pm * 256 + wr * 64 + fr, col0 = u.pn * 256 + wc * 32 + 8 * fq;
#pragma unroll
        for (int ai = 0; ai < 2; ++ai)
#pragma unroll
            for (int m = 0; m < 4; ++m)
#pragma unroll
                for (int bj = 0; bj < 2; ++bj)
                    *(f16x8*)(O + (size_t)(row0 + ai * 128 + m * 16) * ldc + col0 + bj * 128) = pack8h(acc[ai][bj][m][0], acc[ai][bj][m][1]);
    }
};
struct Glu {
    static constexpr bool PERM = true;
    const f16* G; const float* bglu; f16* MIX; float* ss;
    __device__ __forceinline__ void operator()(const Acc& acc, const Unit& u, int wr, int wc, int fr, int fq) const {
        const int row0 = u.pm * 256 + wr * 64 + fr, col0 = u.pn * 256 + wc * 32 + 8 * fq;
        f32x4 bv[2][2];
#pragma unroll
        for (int bj = 0; bj < 2; ++bj)
#pragma unroll
            for (int n = 0; n < 2; ++n) bv[bj][n] = *(const f32x4*)(bglu + col0 + bj * 128 + 4 * n);
        f16x8 gy[2][2];
#pragma unroll
        for (int bj = 0; bj < 2; ++bj) gy[0][bj] = *(const f16x8*)(G + (size_t)row0 * 1024 + col0 + bj * 128);
#pragma unroll
        for (int s = 0; s < 8; ++s) { const int ai = s >> 2, m = s & 3, row = row0 + ai * 128 + m * 16; float sq = 0.f;
            if (s < 7) { const int rown = row0 + ((s + 1) >> 2) * 128 + ((s + 1) & 3) * 16;
#pragma unroll
                for (int bj = 0; bj < 2; ++bj) gy[(s + 1) & 1][bj] = *(const f16x8*)(G + (size_t)rown * 1024 + col0 + bj * 128); }
#pragma unroll
            for (int bj = 0; bj < 2; ++bj) { f32x4 o[2];
#pragma unroll
                for (int n = 0; n < 2; ++n)
#pragma unroll
                    for (int i = 0; i < 4; ++i) { const float z = acc[ai][bj][m][n][i] + bv[bj][n][i]; const float v = (float)gy[s & 1][bj][4 * n + i] * __builtin_amdgcn_rcpf(1.0f + __expf(-z)); o[n][i] = v; sq += v * v; }
                *(f16x8*)(MIX + (size_t)row * 2048 + 1024 + col0 + bj * 128) = pack8h(o[0], o[1]); }
            sq = quad_sum(sq);
            if (fq == 0) ss[(size_t)row * 16 + u.pn * 4 + wc] = sq; }
    }
};
struct OutProj {
    static constexpr bool PERM = true;
    const float* X; f16* HA; const float* ss_att; const float* ss_ssm; float* ss_h; unsigned char* H8;
    __device__ __forceinline__ void midscale_store(LAS float* msl, const Unit& u, int tid) const {
        if (tid < 256) { const int row = u.pm * 256 + tid; msl[tid] = rstd_of(ss_full<8>(ss_att + (size_t)row * 8), 1.0f / 1024.f) / rstd_of(ss_full<16>(ss_ssm + (size_t)row * 16), 1.0f / 1024.f); }
    }
    __device__ __forceinline__ void operator()(const Acc& acc, const Unit& u, int wr, int wc, int fr, int fq) const {
        const int row0 = u.pm * 256 + wr * 64 + fr, col0 = u.pn * 256 + wc * 32 + 8 * fq;
        float rsv[8];
#pragma unroll
        for (int s = 0; s < 8; ++s) rsv[s] = ss_quad<16>(ss_ssm + (size_t)(row0 + (s >> 2) * 128 + (s & 3) * 16) * 16, fq);
        f32x4 xv[2][4];
#pragma unroll
        for (int q = 0; q < 4; ++q) xv[0][q] = *(const f32x4*)(X + (size_t)row0 * DM + col0 + (q >> 1) * 128 + (q & 1) * 4);
#pragma unroll
        for (int s = 0; s < 8; ++s) { const int ai = s >> 2, m = s & 3, row = row0 + ai * 128 + m * 16; const float rs = rstd_of(rsv[s], 1.0f / 1024.f); float sq = 0.f;
            if (s < 7) { const int rown = row0 + ((s + 1) >> 2) * 128 + ((s + 1) & 3) * 16;
#pragma unroll
                for (int q = 0; q < 4; ++q) xv[(s + 1) & 1][q] = *(const f32x4*)(X + (size_t)rown * DM + col0 + (q >> 1) * 128 + (q & 1) * 4); }
#pragma unroll
            for (int bj = 0; bj < 2; ++bj) { f32x4 h[2];
#pragma unroll
                for (int n = 0; n < 2; ++n) { h[n] = xv[s & 1][bj * 2 + n] + acc[ai][bj][m][n] * rs; sq += (h[n][0] * h[n][0] + h[n][1] * h[n][1]) + (h[n][2] * h[n][2] + h[n][3] * h[n][3]); }
                *(f16x8*)(HA + (size_t)row * DM + col0 + bj * 128) = pack8h(h[0], h[1]);
                *(u32x2*)(H8 + (size_t)row * DM + col0 + bj * 128) = pack8q(h[0] * XH_SCALE, h[1] * XH_SCALE); }
            sq = quad_sum(sq);
            if (fq == 0) ss_h[(size_t)row * 32 + u.pn * 4 + wc] = sq; }
    }
};
struct CrossPreOut {
    static constexpr bool PERM = true;
    unsigned char* WKT; unsigned char* VWT;
    __device__ __forceinline__ void operator()(const Acc& acc, const Unit& u, int wr, int wc, int fr, int fq) const {
        const int b = u.pm >> 2, hc = u.pm & 3, r0 = wr * 64 + fr, c0 = wc * 32 + 8 * fq;
        unsigned char* O; int ldc; float sc;
        if (u.aux == 0) { O = WKT + ((size_t)(b * 1024 + hc * 256)) * DM + u.pn * 256; ldc = DM; sc = XK_SCALE; }
        else { O = VWT + ((size_t)(b * DM + u.pn * 256)) * 1024 + hc * 256; ldc = 1024; sc = XV_SCALE; }
#pragma unroll
        for (int ai = 0; ai < 2; ++ai)
#pragma unroll
            for (int m = 0; m < 4; ++m)
#pragma unroll
                for (int bj = 0; bj < 2; ++bj)
                    *(u32x2*)(O + (size_t)(r0 + ai * 128 + m * 16) * ldc + c0 + bj * 128) = pack8q(acc[ai][bj][m][0] * sc, acc[ai][bj][m][1] * sc);
    }
};
struct CrossSoftmax {
    static constexpr bool PERM = true;
    unsigned char* P; const float* ss_h; LAS float* xch;
    __device__ __forceinline__ void operator()(const Acc& acc, const Unit& u, int wr, int wc, int fr, int fq) const {
        const int rt0 = wr * 64 + fr, row0 = u.pm * 256 + rt0, col0 = u.pn * 256 + wc * 32 + 8 * fq;
        LAS float* xm = xch; LAS float* xs = xch + 4 * 256;
        float rs[8];
#pragma unroll
        for (int s = 0; s < 8; ++s) rs[s] = rstd_of(ss_quad<32>(ss_h + (size_t)(row0 + (s >> 2) * 128 + (s & 3) * 16) * 32, fq), 1.0f / 2048.f) * (1.0f / (XH_SCALE * XK_SCALE));
#pragma unroll
        for (int s = 0; s < 8; ++s) { const int ai = s >> 2, m = s & 3; float mx = -__builtin_inff();
#pragma unroll
            for (int bj = 0; bj < 2; ++bj)
#pragma unroll
                for (int n = 0; n < 2; ++n)
#pragma unroll
                    for (int i = 0; i < 4; ++i) mx = fmaxf(mx, acc[ai][bj][m][n][i]);
            mx = fmaxf(mx, __shfl_xor(mx, 16)); mx = fmaxf(mx, __shfl_xor(mx, 32));
            if (fq == 0) xm[wc * 256 + ai * 128 + rt0 + m * 16] = mx * rs[s]; }
        asm volatile("s_waitcnt lgkmcnt(0)" ::: "memory"); __builtin_amdgcn_s_barrier(); asm volatile("" ::: "memory");
        float mrow[8];
#pragma unroll
        for (int s = 0; s < 8; ++s) { const int r = (s >> 2) * 128 + rt0 + (s & 3) * 16; mrow[s] = fmaxf(fmaxf(xm[r], xm[256 + r]), fmaxf(xm[512 + r], xm[768 + r])) * 1.4426950408889634f; }
#pragma unroll
        for (int s = 0; s < 8; ++s) { const int ai = s >> 2, m = s & 3; const float sc = rs[s] * 1.4426950408889634f; float sum = 0.f;
#pragma unroll
            for (int bj = 0; bj < 2; ++bj)
#pragma unroll
                for (int n = 0; n < 2; ++n)
#pragma unroll
                    for (int i = 0; i < 4; ++i) sum += __builtin_amdgcn_exp2f(fmaf(acc[ai][bj][m][n][i], sc, -mrow[s]));
            sum = quad_sum(sum);
            if (fq == 0) xs[wc * 256 + ai * 128 + rt0 + m * 16] = sum; }
        asm volatile("s_waitcnt lgkmcnt(0)" ::: "memory"); __builtin_amdgcn_s_barrier(); asm volatile("" ::: "memory");
#pragma unroll
        for (int s = 0; s < 8; ++s) { const int ai = s >> 2, m = s & 3, r = ai * 128 + rt0 + m * 16; const float sc = rs[s] * 1.4426950408889634f;
            const float inv = XP_SCALE * __builtin_amdgcn_rcpf((xs[r] + xs[256 + r]) + (xs[512 + r] + xs[768 + r]));
#pragma unroll
            for (int bj = 0; bj < 2; ++bj) { f32x4 o[2];
#pragma unroll
                for (int n = 0; n < 2; ++n)
#pragma unroll
                    for (int i = 0; i < 4; ++i) o[n][i] = __builtin_amdgcn_exp2f(fmaf(acc[ai][bj][m][n][i], sc, -mrow[s])) * inv;
                *(u32x2*)(P + (size_t)(row0 + ai * 128 + m * 16) * 1024 + col0 + bj * 128) = pack8q(o[0], o[1]); } }
    }
};
struct CrossO {
    static constexpr bool PERM = true;
    f16* H; float* ss_h2;
    __device__ __forceinline__ void operator()(const Acc& acc, const Unit& u, int wr, int wc, int fr, int fq) const {
        const int row0 = u.pm * 256 + wr * 64 + fr, col0 = u.pn * 256 + wc * 32 + 8 * fq;
        f16x8 xv[2][2];
#pragma unroll
        for (int bj = 0; bj < 2; ++bj) xv[0][bj] = *(const f16x8*)(H + (size_t)row0 * DM + col0 + bj * 128);
#pragma unroll
        for (int s = 0; s < 8; ++s) { const int ai = s >> 2, m = s & 3, row = row0 + ai * 128 + m * 16; float sq = 0.f;
            if (s < 7) { const int rown = row0 + ((s + 1) >> 2) * 128 + ((s + 1) & 3) * 16;
#pragma unroll
                for (int bj = 0; bj < 2; ++bj) xv[(s + 1) & 1][bj] = *(const f16x8*)(H + (size_t)rown * DM + col0 + bj * 128); }
#pragma unroll
            for (int bj = 0; bj < 2; ++bj) { f32x4 h[2];
#pragma unroll
                for (int n = 0; n < 2; ++n)
#pragma unroll
                    for (int i = 0; i < 4; ++i) { h[n][i] = (float)xv[s & 1][bj][4 * n + i] + acc[ai][bj][m][n][i] * (1.0f / (XP_SCALE * XV_SCALE)); sq += h[n][i] * h[n][i]; }
                *(f16x8*)(H + (size_t)row * DM + col0 + bj * 128) = pack8h(h[0], h[1]); }
            sq = quad_sum(sq);
            if (fq == 0) ss_h2[(size_t)row * 32 + u.pn * 4 + wc] = sq; }
    }
};
struct ExpertGU {
    static constexpr bool PERM = true;
    unsigned char* ACT; const float* bgu;
    __device__ __forceinline__ void operator()(const Acc& acc, const Unit& u, int wr, int wc, int fr, int fq) const {
        const int row0 = u.pm * 256 + wr * 64 + fr, f0 = u.pn * 128 + wc * 32 + 8 * fq;
        const float* bg = bgu + (size_t)u.aux * (2 * DFF) + f0;
        f32x4 bgv[2], blv[2];
#pragma unroll
        for (int n = 0; n < 2; ++n) { bgv[n] = *(const f32x4*)(bg + 4 * n); blv[n] = *(const f32x4*)(bg + DFF + 4 * n); }
        const f32x2 winv = {WQ_INV, WQ_INV}, one2 = {1.0f, 1.0f}, kexp = {-1.702f * 1.4426950408889634f, -1.702f * 1.4426950408889634f};
#pragma unroll
        for (int ai = 0; ai < 2; ++ai)
#pragma unroll
            for (int m = 0; m < 4; ++m) { const int row = row0 + ai * 128 + m * 16; f32x4 o[2];
#pragma unroll
                for (int n = 0; n < 2; ++n)
#pragma unroll
                    for (int p = 0; p < 2; ++p) {
                        const f32x2 ag = {acc[ai][0][m][n][2 * p], acc[ai][0][m][n][2 * p + 1]}, al = {acc[ai][1][m][n][2 * p], acc[ai][1][m][n][2 * p + 1]};
                        const f32x2 bg2 = {bgv[n][2 * p], bgv[n][2 * p + 1]}, bl2 = {blv[n][2 * p], blv[n][2 * p + 1]};
                        f32x2 g = __builtin_elementwise_fma(ag, winv, bg2), l = __builtin_elementwise_fma(al, winv, bl2);
                        g[0] = fminf(g[0], 7.0f); g[1] = fminf(g[1], 7.0f);
                        l[0] = __builtin_amdgcn_fmed3f(l[0], -7.0f, 7.0f); l[1] = __builtin_amdgcn_fmed3f(l[1], -7.0f, 7.0f);
                        const f32x2 t = g * kexp;
                        f32x2 d = {__builtin_amdgcn_exp2f(t[0]), __builtin_amdgcn_exp2f(t[1])};
                        d = d + one2;
                        const f32x2 r = {__builtin_amdgcn_rcpf(d[0]), __builtin_amdgcn_rcpf(d[1])};
                        const f32x2 res = (g * r) * (l + one2);
                        o[n][2 * p] = res[0]; o[n][2 * p + 1] = res[1]; }
                __builtin_nontemporal_store(pack8q(o[0], o[1]), (u32x2*)(ACT + (size_t)row * DFF + f0)); }
    }
};
struct ExpertDown {
    static constexpr bool PERM = true;
    unsigned char* YS; const float* bdn;
    __device__ __forceinline__ void operator()(const Acc& acc, const Unit& u, int wr, int wc, int fr, int fq) const {
        const int row0 = u.pm * 256 + wr * 64 + fr, col0 = u.pn * 256 + wc * 32 + 8 * fq;
        f32x4 bv[2][2];
#pragma unroll
        for (int bj = 0; bj < 2; ++bj)
#pragma unroll
            for (int n = 0; n < 2; ++n) bv[bj][n] = *(const f32x4*)(bdn + (size_t)u.aux * DM + col0 + bj * 128 + 4 * n);
#pragma unroll
        for (int ai = 0; ai < 2; ++ai)
#pragma unroll
            for (int m = 0; m < 4; ++m)
#pragma unroll
                for (int bj = 0; bj < 2; ++bj)
                    *(u32x2*)(YS + (size_t)(row0 + ai * 128 + m * 16) * DM + col0 + bj * 128) = pack8q(acc[ai][bj][m][0] * WQ_INV + bv[bj][0], acc[ai][bj][m][1] * WQ_INV + bv[bj][1]);
    }
};
}

template <bool GATHER_>
struct MoeOrder {
    static constexpr bool GATHER = GATHER_;
    const LAS int* tab; const char* Abase; const char* Wbase; const int* rowtok; size_t wstride; int KB, nN, G, c;
    __device__ bool next(int i, pg8::Unit& u) const {
        const int npg = nN >> 2, x = c & 7, j = c >> 3, rbg = i * (G / nN) + 8 * (x / npg) + (j >> 2), pnl = 4 * (x % npg) + (j & 3), NB = tab[32];
        if (rbg >= NB) return false;
        int e = 0;
#pragma unroll
        for (int j = 1; j < NE; ++j) e += (tab[j] <= rbg) ? 1 : 0;
        u.pm = __builtin_amdgcn_readfirstlane(rbg); u.pn = __builtin_amdgcn_readfirstlane(pnl); u.aux = __builtin_amdgcn_readfirstlane(e); return true;
    }
    __device__ __forceinline__ int pitch_a() const { return KB; }
    __device__ __forceinline__ int pitch_b() const { return KB; }
    __device__ __forceinline__ const char* a_ptr(const pg8::Unit& u) const { return GATHER ? Abase : Abase + (size_t)u.pm * 256 * KB; }
    __device__ __forceinline__ const char* b_ptr(const pg8::Unit& u) const { return Wbase + (size_t)u.aux * wstride + (size_t)u.pn * 256 * KB; }
    __device__ __forceinline__ unsigned a_row(const pg8::Unit& u, int r) const {
        if (!GATHER) return (unsigned)r;
        const int slot = (u.pm - tab[u.aux]) * 256 + r;
        return slot < tab[64 + u.aux] ? (unsigned)rowtok[(size_t)u.aux * M + slot] : 0u;
    }
};

namespace fox {
constexpr float SCALE = 0.08838834764831845f;
constexpr float THR = 8.f;
constexpr int NW = 8, QBLK = 32, KVBLK = 64, QB = NW * QBLK, D = 128, PIT = 1024, OPIT = 2048;
constexpr int SHM_V = KVBLK * D * 2, SHM_K = KVBLK * D * 2;
constexpr int OFF_WS = 2 * SHM_V + 2 * SHM_K, OFF_CN = OFF_WS + NW * 96 * 4, OFF_VOTE = OFF_CN + SEQ * 4, LDS_BYTES = OFF_VOTE + 64;
constexpr float CUT = 18.0f;
typedef short s16x4 __attribute__((ext_vector_type(4)));
#define KSWZ(row, colB) ((row) * 256 + ((colB) ^ (((row) & 7) << 4)))
#define SBAR() __builtin_amdgcn_sched_barrier(0)
__device__ __forceinline__ int v_st(int k, int c) { const int kk = (k & ~0xC) | ((k & 4) << 1) | ((k & 8) >> 1); return ((kk >> 3) * 4 + (c >> 5)) * 512 + ((kk & 7) * 32 + (c & 31)) * 2; }
__device__ __forceinline__ int v_rd_base(int lane) { return ((lane & 3) << 3) | (((lane >> 2) & 3) << 6) | (((lane >> 4) & 1) << 5) | (((lane >> 5) & 1) << 8); }
constexpr int v_rd_off(int d0, int ks, int half) { return d0 * 512 + ks * 4096 + half * 2048; }
__device__ __forceinline__ int crow(int r, int hi) { return (r & 3) + 8 * (r >> 2) + 4 * hi; }
__device__ __forceinline__ void mask_tile(f32x16& p0, f32x16& p1, int dq) {
    const float NEG = -__builtin_inff();
#pragma unroll
    for (int r = 0; r < 16; ++r) {
        const int c = (r & 3) + 8 * (r >> 2);
        if (dq - c < 0) p0[r] = NEG;
        if (dq - c - 32 < 0) p1[r] = NEG;
    }
}
__device__ __forceinline__ void partialSM(f32x16& p0, f32x16& p1, float& m_reg, float& mn, float& alpha) {
    float pmax = p0[0];
#pragma unroll
    for (int r = 1; r < 16; ++r) pmax = fmaxf(pmax, p0[r]);
#pragma unroll
    for (int r = 0; r < 16; ++r) pmax = fmaxf(pmax, p1[r]);
    { auto rr = __builtin_amdgcn_permlane32_swap(__float_as_uint(pmax), __float_as_uint(pmax), false, false);
      pmax = fmaxf(__uint_as_float(rr[0]), __uint_as_float(rr[1])); }
    constexpr float C2 = 1.4426950408889634f * SCALE;
    if (__builtin_expect(__all((pmax - m_reg) * SCALE <= THR), 1)) { mn = m_reg; alpha = 1.f; }
    else { mn = fmaxf(m_reg, pmax); alpha = __builtin_amdgcn_exp2f((m_reg - mn) * C2); m_reg = mn; }
    const float mnL = -mn * C2;
#pragma unroll
    for (int r = 0; r < 16; ++r) p0[r] = fmaf(p0[r], C2, mnL);
#pragma unroll
    for (int r = 0; r < 16; ++r) p1[r] = fmaf(p1[r], C2, mnL);
#pragma unroll
    for (int r = 0; r < 16; ++r) p0[r] = __builtin_amdgcn_exp2f(p0[r]);
}
__device__ __forceinline__ void finishSM(f32x16& p0, f32x16& p1, float alpha, float& l_reg, f16x8& pa0, f16x8& pa1, f16x8& pa2, f16x8& pa3) {
#pragma unroll
    for (int r = 0; r < 16; ++r) p1[r] = __builtin_amdgcn_exp2f(p1[r]);
    float ps = 0;
#pragma unroll
    for (int r = 0; r < 16; ++r) ps += p0[r];
#pragma unroll
    for (int r = 0; r < 16; ++r) ps += p1[r];
    { auto rr = __builtin_amdgcn_permlane32_swap(__float_as_uint(ps), __float_as_uint(ps), false, false);
      ps = __uint_as_float(rr[0]) + __uint_as_float(rr[1]); }
    l_reg = l_reg * alpha + ps;
#define PK4(P, B_, OUT) do { unsigned a0 = pk2h(P[B_+0], P[B_+1]), a1 = pk2h(P[B_+2], P[B_+3]);                          \
        unsigned b0 = pk2h(P[B_+4], P[B_+5]), b1 = pk2h(P[B_+6], P[B_+7]);                                             \
        auto r0 = __builtin_amdgcn_permlane32_swap(a0, b0, false, false); auto r1 = __builtin_amdgcn_permlane32_swap(a1, b1, false, false); \
        u32x4 w = {r0[0], r1[0], r0[1], r1[1]}; OUT = __builtin_bit_cast(f16x8, w); } while (0)
    PK4(p0, 0, pa0); PK4(p0, 8, pa1); PK4(p1, 0, pa2); PK4(p1, 8, pa3);
#undef PK4
}
template <int KB>
__device__ __forceinline__ void qkt(f32x16& p0, f32x16& p1, const char* K_lds, int r32, int hi, const f16x8* qr, const LAS float* cnp) {
#pragma unroll
    for (int g = 0; g < 4; ++g) { const f32x4 a = *(const LAS f32x4*)(cnp + 8 * g), b = *(const LAS f32x4*)(cnp + 32 + 8 * g);
#pragma unroll
        for (int i = 0; i < 4; ++i) { p0[4 * g + i] = a[i]; p1[4 * g + i] = b[i]; } }
    const char* kb[4];
#pragma unroll
    for (int dd = 0; dd < 4; ++dd) kb[dd] = K_lds + KB * SHM_K + KSWZ(r32, (dd * 16 + hi * 8) * 2);
#pragma unroll
    for (int d0 = 0; d0 < 8; ++d0) { const char* a = kb[d0 & 3] + (d0 >> 2) * 128;
        f16x8 b0 = *reinterpret_cast<const f16x8*>(a);
        f16x8 b1 = *reinterpret_cast<const f16x8*>(a + 32 * 256);
        p0 = __builtin_amdgcn_mfma_f32_32x32x16_f16(b0, qr[d0], p0, 0, 0, 0);
        p1 = __builtin_amdgcn_mfma_f32_32x32x16_f16(b1, qr[d0], p1, 0, 0, 0); }
}
template <int VB>
__device__ __forceinline__ void pv_tile(f32x16* o, int vb0, f16x8 pa0, f16x8 pa1, f16x8 pa2, f16x8 pa3) {
#define TRRD(dst, off) asm volatile("ds_read_b64_tr_b16 %0, %1 offset:%2" : "=&v"(dst) : "v"(vb0), "i"(off) : "memory")
#define H8(l, h) __builtin_bit_cast(f16x8, (u32x4){__builtin_bit_cast(u32x2, l)[0], __builtin_bit_cast(u32x2, l)[1], __builtin_bit_cast(u32x2, h)[0], __builtin_bit_cast(u32x2, h)[1]})
#define PV_D0(d0) do { s16x4 l0, l1, l2, l3, h0, h1, h2, h3; constexpr int b_ = VB * SHM_V + v_rd_off(d0, 0, 0); \
        TRRD(l0, b_); TRRD(h0, b_ + 2048); TRRD(l1, b_ + 4096); TRRD(h1, b_ + 6144); TRRD(l2, b_ + 8192); TRRD(h2, b_ + 10240); TRRD(l3, b_ + 12288); TRRD(h3, b_ + 14336); \
        asm volatile("s_waitcnt lgkmcnt(0)" ::: "memory"); SBAR();   \
        o[d0] = __builtin_amdgcn_mfma_f32_32x32x16_f16(pa0, H8(l0, h0), o[d0], 0, 0, 0);   \
        o[d0] = __builtin_amdgcn_mfma_f32_32x32x16_f16(pa1, H8(l1, h1), o[d0], 0, 0, 0);   \
        o[d0] = __builtin_amdgcn_mfma_f32_32x32x16_f16(pa2, H8(l2, h2), o[d0], 0, 0, 0);   \
        o[d0] = __builtin_amdgcn_mfma_f32_32x32x16_f16(pa3, H8(l3, h3), o[d0], 0, 0, 0); } while (0)
    PV_D0(0); PV_D0(1); PV_D0(2); PV_D0(3);
#undef PV_D0
#undef H8
#undef TRRD
}
struct BlockRef { const f16* Q; const f16* K; const f16* V; f16* O; float* ss; int P0; float kb; };
struct Seam { f16x8 qr[8]; f16x8 st_v0, st_v1, st_k0, st_k1; };
#define ROW(p, k0, rr) ((p) + (size_t)((k0) + (rr)) * PIT + sc)
#define VMW() asm volatile("s_waitcnt vmcnt(0)" ::: "memory")
#define VMWN(n) asm volatile("s_waitcnt vmcnt(%0)" :: "i"(n) : "memory")
#define SLOAD_H(Kp, Vp, k0) do { S.st_v0 = *(const f16x8*)ROW(Vp, k0, sr); S.st_v1 = *(const f16x8*)ROW(Vp, k0, 32 + sr);              \
                         S.st_k0 = *(const f16x8*)ROW(Kp, k0, sr); S.st_k1 = *(const f16x8*)ROW(Kp, k0, 32 + sr); } while (0)
#define SWRITE_HK(bf) do { *(f16x8*)(K_lds + (bf) * SHM_K + kws) = S.st_k0; *(f16x8*)(K_lds + (bf) * SHM_K + kws + 32 * 256) = S.st_k1; } while (0)
#define SWRITE_HV(bf) do { *(f16x8*)(V_lds + (bf) * SHM_V + vst0) = S.st_v0; *(f16x8*)(V_lds + (bf) * SHM_V + vst1) = S.st_v1; } while (0)
#define SWRITE_H(bf) do { SWRITE_HV(bf); SWRITE_HK(bf); } while (0)
__device__ __forceinline__ int first_kb(int P0) { return P0 + QB - KVBLK; }
__device__ __forceinline__ void prime(const BlockRef& cur, const float* cneg, char* lds, Seam& S) {
    const int tid = opaque_tid(), wid = __builtin_amdgcn_readfirstlane(tid >> 6), lane = tid & 63, r32 = lane & 31, hi = lane >> 5;
    const int sr = tid >> 4, sc = (tid & 15) * 8, kws = KSWZ(sr, sc * 2); char* K_lds = lds + 2 * SHM_V;
    const int kb0 = first_kb(cur.P0);
#pragma unroll
    for (int d0 = 0; d0 < 8; ++d0) S.qr[d0] = *(const f16x8*)(cur.Q + (size_t)(cur.P0 + wid * QBLK + r32) * PIT + d0 * 16 + hi * 8);
    SLOAD_H(cur.K, cur.V, kb0);
    { float* cn = (float*)(lds + OFF_CN);
#pragma unroll
      for (int j = 0; j < 4; ++j) *(f32x4*)(cn + (tid + 512 * j) * 4) = *(const f32x4*)(cneg + (tid + 512 * j) * 4); }
    VMW(); SWRITE_HK(0);
    __syncthreads();
}
__device__ __forceinline__ void block(const BlockRef& cur, const BlockRef& nxt, int tokbase, char* lds, Seam& S) {
    const int tid = opaque_tid(), wid = __builtin_amdgcn_readfirstlane(tid >> 6), lane = tid & 63, r32 = lane & 31, hi = lane >> 5;
    const int NT = cur.P0 / KVBLK + QB / KVBLK;
    const int kbn = first_kb(nxt.P0);
    const int qlo = cur.P0 + wid * QBLK, qm = qlo + r32 - 4 * hi;
    char* V_lds = lds; char* K_lds = lds + 2 * SHM_V;
    float* ws = (float*)(lds + OFF_WS) + wid * 96; float* li_l = ws, * al_l = ws + 32, * qb_l = ws + 64;
    const LAS float* cn = (const LAS float*)(LAS char*)(lds + OFF_CN) + 4 * hi;
    float m_reg = -1e30f, l_reg = 0; f32x16 o[4] = {};
    const int sr = tid >> 4, sc = (tid & 15) * 8, vst0 = v_st(sr, sc), vst1 = v_st(32 + sr, sc), kws = KSWZ(sr, sc * 2);
    const int vb0 = (int)(uintptr_t)V_lds + v_rd_base(lane);
    { float s2 = 0.f;
#pragma unroll
      for (int d0 = 0; d0 < 8; ++d0)
#pragma unroll
          for (int e = 0; e < 8; ++e) { const float x = (float)S.qr[d0][e]; s2 += x * x; }
      auto rr = __builtin_amdgcn_permlane32_swap(__float_as_uint(s2), __float_as_uint(s2), false, false);
      if (hi == 0) qb_l[r32] = sqrtf(__uint_as_float(rr[0]) + __uint_as_float(rr[1])) * cur.kb; }
    volatile LAS unsigned* vote = (volatile LAS unsigned*)(LAS char*)(lds + OFF_VOTE);
    const f16* Kh = cur.K; const f16* Vh = cur.V;
#define RESC(a) do { if (__any((a) < 1.f)) { if (hi == 0) al_l[r32] = (a); asm volatile("s_waitcnt lgkmcnt(0)" ::: "memory");              \
                     for (int d_ = 0; d_ < 4; ++d_) for (int r = 0; r < 16; ++r) o[d_][r] *= al_l[crow(r, hi)]; } } while (0)
#define KBASE(t) ((NT - 1 - (t)) * KVBLK)
#define MASKT(P0_, P1_, t) do { const int kb_ = KBASE(t); if (kb_ + KVBLK - 1 > qlo) mask_tile(P0_, P1_, qm - kb_); } while (0)
    constexpr int NQL = 8;
#define SEAM_K0() do { VMWN(NQL); SWRITE_HK(0); SBAR(); } while (0)
    f32x16 pA0, pA1, pB0, pB1; float mnA, mnB, alA, alB; f16x8 pa0, pa1, pa2, pa3;
    SWRITE_HV(0); SBAR();
    if (NT > 1) { SLOAD_H(Kh, Vh, KBASE(1)); }
    SBAR(); qkt<0>(pA0, pA1, K_lds, r32, hi, S.qr, cn + KBASE(0));
    MASKT(pA0, pA1, 0); partialSM(pA0, pA1, m_reg, mnA, alA);
    if (NT > 1) { VMW(); SWRITE_H(1); }
    __syncthreads();
#define HALF_STEP(PX0, PX1, mnX, alX, PY0, PY1, alY, t, KB, VB, SB) do {                                                      \
        SBAR(); qkt<KB>(PX0, PX1, K_lds, r32, hi, S.qr, cn + KBASE(t));                                                       \
        finishSM(PY0, PY1, alY, l_reg, pa0, pa1, pa2, pa3); SBAR();                                                           \
        if ((t) + 1 < NT) { SLOAD_H(Kh, Vh, KBASE((t) + 1)); SBAR(); }                                                        \
        pv_tile<VB>(o, vb0, pa0, pa1, pa2, pa3); MASKT(PX0, PX1, (t)); partialSM(PX0, PX1, m_reg, mnX, alX);                  \
        __syncthreads();                                                                                                      \
        if ((t) + 1 < NT) { VMW(); SWRITE_H(SB); }                                                                            \
        RESC(alX); __syncthreads(); } while (0)
    bool broke = false;
    for (int t = 1; t + 1 < NT; t += 2) {
        HALF_STEP(pB0, pB1, mnB, alB, pA0, pA1, alA, t, 1, 0, 0);
        HALF_STEP(pA0, pA1, mnA, alA, pB0, pB1, alB, t + 1, 0, 1, 1);
        if (t + 2 < NT) {
            const float cl = *((const LAS float*)(LAS char*)(lds + OFF_CN) + KBASE(t + 2) + KVBLK - 1);
            const bool can = __all((qb_l[r32] + cl - m_reg) * SCALE < -CUT);
            if (lane == 0) vote[wid] = can ? 1u : 0u;
            asm volatile("s_waitcnt lgkmcnt(0)" ::: "memory"); __syncthreads();
            unsigned all_ = 1u;
#pragma unroll
            for (int w_ = 0; w_ < NW; ++w_) all_ &= vote[w_];
            __syncthreads();
            if (all_) { broke = true; break; }
        }
    }
    const bool even = !broke;
    if (even) { SBAR(); qkt<1>(pB0, pB1, K_lds, r32, hi, S.qr, cn + KBASE(NT - 1)); SBAR(); }
    SLOAD_H(nxt.K, nxt.V, kbn); SBAR();
#pragma unroll
    for (int d0 = 0; d0 < 8; ++d0) S.qr[d0] = *(const f16x8*)(nxt.Q + (size_t)(nxt.P0 + wid * QBLK + r32) * PIT + d0 * 16 + hi * 8);
    SBAR();
    finishSM(pA0, pA1, alA, l_reg, pa0, pa1, pa2, pa3); SBAR();
    pv_tile<0>(o, vb0, pa0, pa1, pa2, pa3);
    if (even) { MASKT(pB0, pB1, NT - 1); partialSM(pB0, pB1, m_reg, mnB, alB); __syncthreads(); RESC(alB);
        finishSM(pB0, pB1, alB, l_reg, pa0, pa1, pa2, pa3); SBAR(); pv_tile<1>(o, vb0, pa0, pa1, pa2, pa3); }
    SBAR(); SEAM_K0();
    if (hi == 0) li_l[r32] = l_reg; asm volatile("s_waitcnt lgkmcnt(0)" ::: "memory");
    f16* Ow = cur.O + (size_t)(cur.P0 + wid * QBLK) * OPIT;
#pragma unroll
    for (int r = 0; r < 16; ++r) { const int orow = crow(r, hi); const float rl = __builtin_amdgcn_rcpf(li_l[orow]); float sq = 0.f;
#pragma unroll
        for (int d0 = 0; d0 < 4; ++d0) { const float v = o[d0][r] * rl; sq += v * v;
            const float vn = __shfl_xor(v, 1);
            if ((r32 & 1) == 0) *(unsigned*)(Ow + (size_t)orow * OPIT + d0 * 32 + r32) = pk2h(v, vn); }
        sq += __shfl_xor(sq, 1); sq += __shfl_xor(sq, 2); sq += __shfl_xor(sq, 4); sq += __shfl_xor(sq, 8); sq += __shfl_xor(sq, 16);
        if (r32 == 0) cur.ss[(size_t)(tokbase + cur.P0 + wid * QBLK + orow) * 8] = sq; }
    __syncthreads();
#undef RESC
#undef KBASE
#undef MASKT
#undef SEAM_K0
#undef HALF_STEP
}
#undef ROW
#undef VMW
#undef VMWN
#undef SLOAD_H
#undef SWRITE_HK
#undef SWRITE_HV
#undef SWRITE_H
__device__ __forceinline__ void item(int bh, int x, const f16* Q, const f16* K, const f16* V, f16* MIX, float* ss_att, const float* cneg, const float* kmax, char* lds) {
    const int b = bh >> 3, h = bh & 7; const size_t base = (size_t)b * SEQ * PIT + h * AD;
    BlockRef r0, r1;
    r0.kb = sqrtf((kmax[(bh * 4) * KM_STRIDE] + kmax[(bh * 4 + 1) * KM_STRIDE] + kmax[(bh * 4 + 2) * KM_STRIDE] + kmax[(bh * 4 + 3) * KM_STRIDE]) * 1.004f);
    r0.Q = Q + base; r0.K = K + base; r0.V = V + base; r0.O = MIX + (size_t)b * SEQ * OPIT + h * AD; r0.ss = ss_att + h; r0.P0 = x * QB;
    r1 = r0; r1.P0 = (SEQ / QB - 1 - x) * QB;
    Seam S;
    prime(r0, cneg + (size_t)bh * SEQ, lds, S);
    BlockRef rz = r0; rz.P0 = 0;
    block(r0, r1, b * SEQ, lds, S);
    block(r1, rz, b * SEQ, lds, S);
}
}

namespace xat {
using namespace fox;
constexpr int CHB = 65536;
constexpr int LDS_BYTES = 2 * CHB + NW * 64 * 4;
__device__ __forceinline__ void unit(int b, int hc, int qb, const f16* QC, const f16* KVC, f16* OC, char* lds) {
    const int tid = opaque_tid(), wid = __builtin_amdgcn_readfirstlane(tid >> 6), lane = tid & 63, r32 = lane & 31, hi = lane >> 5;
    const int sr = tid >> 4, sc = (tid & 15) * 8, kws = KSWZ(sr, sc * 2), vst0 = v_st(sr, sc), vst1 = v_st(32 + sr, sc);
    const int row = b * SEQ + qb * QB + wid * QBLK + r32;
    const f16* Qrow = QC + (size_t)row * DM + hc * CD + hi * 8;
    const f16* Kb = KVC + (size_t)(b * MEML) * (2 * DM) + hc * CD + sc;
    const f16* Vb = Kb + DM;
    float* li_l = (float*)(lds + 2 * CHB) + wid * 64;
    f16x8 st[8];
#define XLOAD(P, ch) do { _Pragma("unroll") for (int kt = 0; kt < 4; ++kt) { st[2 * kt] = *(const f16x8*)((P) + (size_t)(kt * 64 + sr) * (2 * DM) + (ch) * 128); \
                                                                            st[2 * kt + 1] = *(const f16x8*)((P) + (size_t)(kt * 64 + 32 + sr) * (2 * DM) + (ch) * 128); } } while (0)
#define XWRITE_K(buf) do { _Pragma("unroll") for (int kt = 0; kt < 4; ++kt) { *(f16x8*)(lds + (buf) * CHB + kt * 16384 + kws) = st[2 * kt]; *(f16x8*)(lds + (buf) * CHB + kt * 16384 + kws + 32 * 256) = st[2 * kt + 1]; } } while (0)
#define XWRITE_V(buf) do { _Pragma("unroll") for (int kt = 0; kt < 4; ++kt) { *(f16x8*)(lds + (buf) * CHB + kt * 16384 + vst0) = st[2 * kt]; *(f16x8*)(lds + (buf) * CHB + kt * 16384 + vst1) = st[2 * kt + 1]; } } while (0)
    f32x16 p[4][2];
#pragma unroll
    for (int kt = 0; kt < 4; ++kt) { p[kt][0] = f32x16{}; p[kt][1] = f32x16{}; }
    XLOAD(Kb, 0); asm volatile("s_waitcnt vmcnt(0)" ::: "memory"); XWRITE_K(0); __syncthreads();
#pragma unroll 1
    for (int c = 0; c < 4; ++c) {
        f16x8 qr[8];
#pragma unroll
        for (int d0 = 0; d0 < 8; ++d0) qr[d0] = *(const f16x8*)(Qrow + c * 128 + d0 * 16);
        if (c < 3) XLOAD(Kb, c + 1); else XLOAD(Vb, 0);
        const char* kbuf = lds + (c & 1) * CHB;
#pragma unroll
        for (int kt = 0; kt < 4; ++kt) {
            const char* kb[4];
#pragma unroll
            for (int dd = 0; dd < 4; ++dd) kb[dd] = kbuf + kt * 16384 + KSWZ(r32, (dd * 16 + hi * 8) * 2);
#pragma unroll
            for (int d0 = 0; d0 < 8; ++d0) { const char* a = kb[d0 & 3] + (d0 >> 2) * 128;
                const f16x8 b0 = *reinterpret_cast<const f16x8*>(a), b1 = *reinterpret_cast<const f16x8*>(a + 32 * 256);
                p[kt][0] = __builtin_amdgcn_mfma_f32_32x32x16_f16(b0, qr[d0], p[kt][0], 0, 0, 0);
                p[kt][1] = __builtin_amdgcn_mfma_f32_32x32x16_f16(b1, qr[d0], p[kt][1], 0, 0, 0); }
        }
        asm volatile("s_waitcnt vmcnt(0)" ::: "memory");
        if (c < 3) XWRITE_K((c + 1) & 1); else XWRITE_V(0);
        __syncthreads();
    }
    float mx = p[0][0][0];
#pragma unroll
    for (int kt = 0; kt < 4; ++kt)
#pragma unroll
        for (int j = 0; j < 2; ++j)
#pragma unroll
            for (int r = 0; r < 16; ++r) mx = fmaxf(mx, p[kt][j][r]);
    { auto rr = __builtin_amdgcn_permlane32_swap(__float_as_uint(mx), __float_as_uint(mx), false, false); mx = fmaxf(__uint_as_float(rr[0]), __uint_as_float(rr[1])); }
    float ps = 0.f; const float mL = -mx * 1.4426950408889634f;
#pragma unroll
    for (int kt = 0; kt < 4; ++kt)
#pragma unroll
        for (int j = 0; j < 2; ++j)
#pragma unroll
            for (int r = 0; r < 16; ++r) { const float e = __builtin_amdgcn_exp2f(fmaf(p[kt][j][r], 1.4426950408889634f, mL)); p[kt][j][r] = e; ps += e; }
    { auto rr = __builtin_amdgcn_permlane32_swap(__float_as_uint(ps), __float_as_uint(ps), false, false); ps = __uint_as_float(rr[0]) + __uint_as_float(rr[1]); }
    f16x8 pa[4][4];
#define PK4(P, B_, OUT) do { unsigned a0 = pk2h(P[B_+0], P[B_+1]), a1 = pk2h(P[B_+2], P[B_+3]);                          \
        unsigned b0 = pk2h(P[B_+4], P[B_+5]), b1 = pk2h(P[B_+6], P[B_+7]);                                             \
        auto r0 = __builtin_amdgcn_permlane32_swap(a0, b0, false, false); auto r1 = __builtin_amdgcn_permlane32_swap(a1, b1, false, false); \
        u32x4 w = {r0[0], r1[0], r0[1], r1[1]}; OUT = __builtin_bit_cast(f16x8, w); } while (0)
#pragma unroll
    for (int kt = 0; kt < 4; ++kt) { PK4(p[kt][0], 0, pa[kt][0]); PK4(p[kt][0], 8, pa[kt][1]); PK4(p[kt][1], 0, pa[kt][2]); PK4(p[kt][1], 8, pa[kt][3]); }
#undef PK4
    if (hi == 0) li_l[r32] = ps;
    asm volatile("s_waitcnt lgkmcnt(0)" ::: "memory");
    float rl[16];
#pragma unroll
    for (int r = 0; r < 16; ++r) rl[r] = __builtin_amdgcn_rcpf(li_l[crow(r, hi)]);
    f16* Ow = OC + (size_t)(b * SEQ + qb * QB + wid * QBLK) * DM + hc * CD;
#pragma unroll 1
    for (int v = 0; v < 4; ++v) {
        if (v < 3) XLOAD(Vb, v + 1);
        f32x16 o[4] = {};
        const int vb0 = (int)(uintptr_t)lds + (v & 1) * CHB + v_rd_base(lane);
        pv_tile<0>(o, vb0, pa[0][0], pa[0][1], pa[0][2], pa[0][3]);
        pv_tile<1>(o, vb0, pa[1][0], pa[1][1], pa[1][2], pa[1][3]);
        pv_tile<2>(o, vb0, pa[2][0], pa[2][1], pa[2][2], pa[2][3]);
        pv_tile<3>(o, vb0, pa[3][0], pa[3][1], pa[3][2], pa[3][3]);
#pragma unroll
        for (int r = 0; r < 16; ++r) { const int orow = crow(r, hi);
#pragma unroll
            for (int d0 = 0; d0 < 4; ++d0) { const float val = o[d0][r] * rl[r]; const float vn = __shfl_xor(val, 1);
                if ((r32 & 1) == 0) *(unsigned*)(Ow + (size_t)orow * DM + v * 128 + d0 * 32 + r32) = pk2h(val, vn); } }
        if (v < 3) { asm volatile("s_waitcnt vmcnt(0)" ::: "memory"); XWRITE_V((v + 1) & 1); }
        __syncthreads();
    }
#undef XLOAD
#undef XWRITE_K
#undef XWRITE_V
}
}
#undef KSWZ
#undef SBAR

namespace ssm {
constexpr int KT_BYTES = 65 * 512;
constexpr int UST = 2064;
constexpr int OFF_U1 = 0, OFF_X = 0, OFF_KT = 34816, OFF_S = 68096, OFF_U3 = 68096, LDS_BYTES = 134144;
static_assert(OFF_X + 128 * 136 * 2 <= OFF_KT && OFF_KT + KT_BYTES <= OFF_S && OFF_S + 128 * 129 * 4 <= LDS_BYTES && OFF_U3 + 32 * UST <= LDS_BYTES && OFF_U1 + 32 * UST <= OFF_S, "ssm LDS map");
__device__ __forceinline__ float gelu_tanh(float x) {
    const float u = 0.7978845608028654f * (x + 0.044715f * x * x * x);
    const float e = __expf(2.0f * u);
    const float th = 1.0f - 2.0f * __builtin_amdgcn_rcpf(e + 1.0f);
    return 0.5f * x * (1.0f + th);
}
__device__ __forceinline__ void stage_u(const f16* src, LAS unsigned char* dst, int tid) {
    u32x4 v[8];
#pragma unroll
    for (int j = 0; j < 8; ++j) v[j] = *(const u32x4*)((const char*)src + (size_t)(tid + 512 * j) * 16);
#pragma unroll
    for (int j = 0; j < 8; ++j) { const int e = tid + 512 * j; *(LAS u32x4*)(dst + (e >> 7) * UST + (e & 127) * 16) = v[j]; }
}
__device__ __forceinline__ void unit(int b, int g, int half, const f16* U, const f16* KT, const f16* MIN, const f16* MOUT, const float* L64, f16* G, LAS unsigned char* lds) {
    const int tid = opaque_tid(), wid = __builtin_amdgcn_readfirstlane(tid >> 6), lane = tid & 63, n16 = lane & 15, kq = lane >> 4;
    const f16* Ug = U + ((size_t)(b * NG + g) * SEQ) * SG;
    const f16* KTg = KT + (size_t)g * (65 * 256); const f16* MINg = MIN + (size_t)g * (128 * 1024); const f16* MOUTg = MOUT + (size_t)g * (1024 * 128);
    LAS float* s_l = (LAS float*)(lds + OFF_S); LAS f16* x_l = (LAS f16*)(lds + OFF_X);
    const int ngrp = 2 * (half + 1);
    const int boff = n16 * UST + ((kq >> 1) * 16 + 8 * (kq & 1)) * 2;
    {
        f16x8 afr[32];
        const f16* arow = MINg + (size_t)(wid * 16 + n16) * 1024 + 8 * kq;
#pragma unroll
        for (int sp = 0; sp < 32; ++sp) afr[sp] = *(const f16x8*)(arow + sp * 32);
#pragma unroll 1
        for (int grp = 0; grp < ngrp; ++grp) {
            stage_u(Ug + (size_t)grp * 32 * 64 * SG, lds + OFF_U1, tid);
            __syncthreads();
            f32x4 acc[2] = {(f32x4){0.f, 0.f, 0.f, 0.f}, (f32x4){0.f, 0.f, 0.f, 0.f}};
#pragma unroll
            for (int sp = 0; sp < 32; ++sp)
#pragma unroll
                for (int cb = 0; cb < 2; ++cb) { const f16x8 bf = *(const LAS f16x8*)(lds + OFF_U1 + boff + cb * 16 * UST + sp * 64);
                    acc[cb] = __builtin_amdgcn_mfma_f32_16x16x32_f16(afr[sp], bf, acc[cb], 0, 0, 0); }
#pragma unroll
            for (int cb = 0; cb < 2; ++cb)
#pragma unroll
                for (int r = 0; r < 4; ++r) s_l[((grp * 2 + cb) * 16 + n16) * 129 + wid * 16 + 4 * kq + r] = acc[cb][r];
            __syncthreads();
        }
    }
    if (tid < 64) {
        const f32x2 l = *(const f32x2*)(L64 + (size_t)(g * 64 + tid) * 2);
        float xr = 0.f, xi = 0.f;
        for (int c = 0; c < 32 * ngrp; ++c) {
            x_l[c * 136 + tid] = (f16)xr; x_l[c * 136 + 64 + tid] = (f16)xi;
            const float sr = s_l[c * 129 + tid], si = s_l[c * 129 + 64 + tid];
            const float nr = l[0] * xr - l[1] * xi + sr, ni = l[0] * xi + l[1] * xr + si;
            xr = nr; xi = ni;
        }
    } else {
        for (int i = tid - 64; i < KT_BYTES / 16; i += 448) *(LAS u32x4*)(lds + OFF_KT + i * 16) = *(const u32x4*)((const char*)KTg + i * 16);
    }
    __syncthreads();
    const LAS f16* ktl = (const LAS f16*)(lds + OFF_KT) + n16 * 16 + 8 * (kq & 1);
    const int lagoff = 1 - (kq >> 1);
#pragma unroll 1
    for (int pass = 2 * half; pass < 2 * half + 2; ++pass) {
        stage_u(Ug + (size_t)pass * 32 * 64 * SG, lds + OFF_U3, tid);
        __syncthreads();
        f32x4 acc[8][2];
#pragma unroll
        for (int ti = 0; ti < 8; ++ti) { acc[ti][0] = (f32x4){0.f, 0.f, 0.f, 0.f}; acc[ti][1] = (f32x4){0.f, 0.f, 0.f, 0.f}; }
#define SSM_RANGE(m) do { const int hi_ = ((wid + 8 * (m)) >> 1) < 31 ? ((wid + 8 * (m)) >> 1) : 31; \
        _Pragma("unroll 2") for (; sp <= hi_; ++sp) { const int s0 = 2 * sp; \
            const f16x8 b0 = *(const LAS f16x8*)(lds + OFF_U3 + boff + sp * 64); \
            const f16x8 b1 = *(const LAS f16x8*)(lds + OFF_U3 + boff + 16 * UST + sp * 64); \
            _Pragma("unroll") for (int ti = (m); ti < 8; ++ti) { const int t = wid + 8 * ti; \
                int li = t - s0 + lagoff; li = li < 0 ? 0 : li; \
                const f16x8 a = *(const LAS f16x8*)(ktl + li * 256); \
                acc[ti][0] = __builtin_amdgcn_mfma_f32_16x16x32_f16(a, b0, acc[ti][0], 0, 0, 0); \
                acc[ti][1] = __builtin_amdgcn_mfma_f32_16x16x32_f16(a, b1, acc[ti][1], 0, 0, 0); } } } while (0)
        { int sp = 0;
          SSM_RANGE(0); SSM_RANGE(1); SSM_RANGE(2); SSM_RANGE(3); SSM_RANGE(4); SSM_RANGE(5); SSM_RANGE(6); SSM_RANGE(7); }
#undef SSM_RANGE
#pragma unroll
        for (int ks = 0; ks < 4; ++ks) {
            const f16x8 b0 = *(const LAS f16x8*)(x_l + ((pass * 2 + 0) * 16 + n16) * 136 + ks * 32 + 8 * kq);
            const f16x8 b1 = *(const LAS f16x8*)(x_l + ((pass * 2 + 1) * 16 + n16) * 136 + ks * 32 + 8 * kq);
#pragma unroll
            for (int ti = 0; ti < 8; ++ti) { const int t = wid + 8 * ti;
                const f16x8 a = *(const f16x8*)(MOUTg + (size_t)(t * 16 + n16) * 128 + ks * 32 + 8 * kq);
                acc[ti][0] = __builtin_amdgcn_mfma_f32_16x16x32_f16(a, b0, acc[ti][0], 0, 0, 0);
                acc[ti][1] = __builtin_amdgcn_mfma_f32_16x16x32_f16(a, b1, acc[ti][1], 0, 0, 0); }
        }
#pragma unroll
        for (int ti = 0; ti < 8; ++ti)
#pragma unroll
            for (int j = 0; j < 2; ++j) { const int t = wid + 8 * ti, c = (pass * 2 + j) * 16 + n16; const size_t tok = (size_t)b * SEQ + 64 * c + t;
                const f32x4 y = acc[ti][j];
                u32x2 w = {pk2h(gelu_tanh(y[0]), gelu_tanh(y[1])), pk2h(gelu_tanh(y[2]), gelu_tanh(y[3]))};
                *(u32x2*)(G + tok * SSMW + g * SG + 4 * kq) = w; }
        __syncthreads();
    }
}
}

constexpr size_t MiB = 1u << 20;
constexpr size_t WS_CTL = 0, CTL_ZERO_BYTES = 65536;
constexpr int CW_BAR = 1024, CW_CNT = CW_BAR + XCD_BAR_WORDS, CNT_STRIDE = 32, CW_KMAX = CW_BAR + 2 * XCD_BAR_WORDS, CW_CLAIM = 15488;
static_assert(CW_BAR + 4 * XCD_BAR_WORDS <= CW_CLAIM && NE * CNT_STRIDE <= XCD_BAR_WORDS && 64 * 32 <= XCD_BAR_WORDS && (CW_CLAIM + 128) * 4 <= (int)CTL_ZERO_BYTES, "CTL map");
constexpr size_t WS_WIN = 1 * MiB;
constexpr size_t WS_WGLU = WS_WIN + (size_t)4096 * 2048 * 2;
constexpr size_t WS_WOUT = WS_WGLU + (size_t)1024 * 1024 * 2;
constexpr size_t WS_WCQ = WS_WOUT + (size_t)2048 * 2048 * 2;
constexpr size_t WS_WCKV = WS_WCQ + (size_t)2048 * 2048 * 2;
constexpr size_t WS_WCO = WS_WCKV + (size_t)4096 * 2048 * 2;
constexpr size_t WS_WR = WS_WCO + (size_t)2048 * 2048 * 2;
constexpr size_t WS_KT = WS_WR + (size_t)32 * 2048 * 2;
constexpr size_t WS_MIN = WS_KT + (size_t)64 * 65 * 256 * 2;
constexpr size_t WS_MOUT = WS_MIN + (size_t)64 * 128 * 1024 * 2;
constexpr size_t WS_L64 = WS_MOUT + (size_t)64 * 1024 * 128 * 2;
constexpr size_t WS_FL = WS_L64 + (size_t)64 * 64 * 8;
constexpr size_t WS_CNEG = WS_FL + (size_t)M * 8 * 4;
constexpr size_t WS_ROUTE = WS_CNEG + (size_t)16 * SEQ * 4;
constexpr size_t WS_ROWTOK = WS_ROUTE + (size_t)M * 4 * 16;
constexpr size_t WS_MEMN = WS_ROWTOK + (size_t)NE * M * 4;
constexpr size_t WS_KVC = WS_MEMN + (size_t)512 * 2048 * 2;
constexpr size_t WS_SSATT = WS_KVC + (size_t)512 * 4096 * 2;
constexpr size_t WS_SSSSM = WS_SSATT + (size_t)M * 8 * 4;
constexpr size_t WS_SSH = WS_SSSSM + (size_t)M * 16 * 4;
constexpr size_t WS_SSH2 = WS_SSH + (size_t)M * 32 * 4;
constexpr size_t WS_XN = 128 * MiB;
constexpr size_t WS_U = WS_XN + 64 * MiB;
constexpr size_t WS_Q = WS_U + 32 * MiB, WS_K = WS_Q + 32 * MiB, WS_V = WS_K + 32 * MiB;
constexpr size_t WS_G = WS_V + 32 * MiB;
constexpr size_t WS_MIX = WS_G + 32 * MiB;
constexpr size_t WS_H = WS_MIX + 64 * MiB;
constexpr size_t WS_HA = WS_H + 128 * MiB;
constexpr size_t WS_QC = WS_HA + 64 * MiB;
constexpr size_t WS_PB = WS_QC, WS_WKT = WS_QC + 32 * MiB, WS_VWT = WS_QC + 40 * MiB;
constexpr size_t WS_OC = WS_QC + 64 * MiB, WS_H8 = WS_OC;
constexpr size_t WS_X2N = WS_OC + 64 * MiB;
constexpr size_t WS_ACT = WS_X2N + 64 * MiB;
constexpr size_t WS_YS = WS_ACT + 288 * MiB;
constexpr size_t WS_WGU = WS_YS + 288 * MiB;
constexpr size_t WS_WDN = WS_WGU + 512 * MiB;
constexpr size_t WS_END = WS_WDN + 256 * MiB;
static_assert(WS_SSH2 + (size_t)M * 32 * 4 <= WS_XN, "small tables fit below 128 MiB");

constexpr int RING_BYTES = 134144 + 0;
constexpr int RING_CAP = 135168;
constexpr int MISC_OFF = RING_CAP;
constexpr int MOE_TAB_OFF = MISC_OFF + 64;
constexpr int XCH_OFF = MISC_OFF + 2048;
constexpr int MSC_OFF = MISC_OFF + 1024;
constexpr int LDS_BYTES = 147456;
static_assert(ssm::LDS_BYTES <= RING_CAP && xat::LDS_BYTES <= RING_CAP && fox::LDS_BYTES <= RING_CAP && pg8::STAGE_BYTES <= RING_CAP && MOE_TAB_OFF + 128 * 4 <= MSC_OFF && MSC_OFF + 1024 <= XCH_OFF && XCH_OFF + 8192 <= LDS_BYTES, "LDS map");

constexpr int NWAVES = 8;

__device__ __forceinline__ void titem_load(f32x4 (&v)[16], const float* W, int ldw, int k0, int c0, int lane) {
    const int kr = lane >> 4, n4 = (lane & 15) * 4;
#pragma unroll
    for (int i = 0; i < 16; ++i) v[i] = __builtin_nontemporal_load((const f32x4*)(W + (size_t)(k0 + 4 * i + kr) * ldw + c0 + n4));
}
template <bool Q8, class RowMap>
__device__ __forceinline__ void titem_store(const f32x4 (&v)[16], int k0, int c0, void* WT, int K, const RowMap& rm, const float* kscale, float mul, LAS float* scr, int lane) {
    const int kr = lane >> 4, n4 = (lane & 15) * 4;
#pragma unroll
    for (int i = 0; i < 16; ++i) { LAS float* d = scr + (4 * i + kr) * 65 + n4; d[0] = v[i][0]; d[1] = v[i][1]; d[2] = v[i][2]; d[3] = v[i][3]; }
    LDS_WAIT(); asm volatile("" ::: "memory");
    const int c = lane & 7;
    float ks[8];
#pragma unroll
    for (int j = 0; j < 8; ++j) ks[j] = kscale ? kscale[k0 + 8 * c + j] * mul : mul;
#pragma unroll
    for (int j = 0; j < 8; ++j) { const int n = (lane >> 3) + 8 * j; const LAS float* s = scr + (8 * c) * 65 + n;
        if constexpr (Q8) { *(u32x2*)((unsigned char*)WT + (size_t)rm(c0 + n) * K + k0 + 8 * c) =
                pack8q((f32x4){s[0 * 65] * ks[0], s[1 * 65] * ks[1], s[2 * 65] * ks[2], s[3 * 65] * ks[3]}, (f32x4){s[4 * 65] * ks[4], s[5 * 65] * ks[5], s[6 * 65] * ks[6], s[7 * 65] * ks[7]}); }
        else { u32x4 o; o.x = pk2h(s[0 * 65] * ks[0], s[1 * 65] * ks[1]); o.y = pk2h(s[2 * 65] * ks[2], s[3 * 65] * ks[3]); o.z = pk2h(s[4 * 65] * ks[4], s[5 * 65] * ks[5]); o.w = pk2h(s[6 * 65] * ks[6], s[7 * 65] * ks[7]);
            *(u32x4*)((f16*)WT + (size_t)rm(c0 + n) * K + k0 + 8 * c) = o; } }
    LDS_WAIT(); asm volatile("" ::: "memory");
}
__device__ __forceinline__ void qitem_load(f32x4 (&v)[16], const float* W, int ldw, int k0, int c0, int lane) {
    const int kr = lane >> 3, n4 = (lane & 7) * 4;
#pragma unroll
    for (int i = 0; i < 16; ++i) v[i] = __builtin_nontemporal_load((const f32x4*)(W + (size_t)(k0 + 8 * i + kr) * ldw + c0 + n4));
}
__device__ __forceinline__ void tr4x4_b8(unsigned a, unsigned b, unsigned c, unsigned d, unsigned (&o)[4]) {
    const unsigned ab0 = __builtin_amdgcn_perm(b, a, 0x05010400), ab1 = __builtin_amdgcn_perm(b, a, 0x07030602);
    const unsigned cd0 = __builtin_amdgcn_perm(d, c, 0x05010400), cd1 = __builtin_amdgcn_perm(d, c, 0x07030602);
    o[0] = __builtin_amdgcn_perm(cd0, ab0, 0x05040100); o[1] = __builtin_amdgcn_perm(cd0, ab0, 0x07060302);
    o[2] = __builtin_amdgcn_perm(cd1, ab1, 0x05040100); o[3] = __builtin_amdgcn_perm(cd1, ab1, 0x07060302);
}
template <class RowMap>
__device__ __forceinline__ void qitem_store(const f32x4 (&v)[16], int k0, int c0, unsigned char* WT, int K, const RowMap& rm, float mul, LAS float* scr, int lane) {
    LAS unsigned* t8 = (LAS unsigned*)scr;
    const int kr = lane >> 3, nq = lane & 7;
#pragma unroll
    for (int i = 0; i < 16; ++i) { const f32x4 x = v[i] * mul; unsigned w = 0;
        w = __builtin_amdgcn_cvt_pk_fp8_f32(x[0], x[1], w, false); w = __builtin_amdgcn_cvt_pk_fp8_f32(x[2], x[3], w, true);
        t8[(8 * i + kr) * 9 + nq] = w; }
    LDS_WAIT(); asm volatile("" ::: "memory");
    const int ng = lane & 7, c = lane >> 3;
    unsigned out[4][4];
#pragma unroll
    for (int blk = 0; blk < 4; ++blk) { const LAS unsigned* p = t8 + (16 * c + 4 * blk) * 9 + ng; unsigned o[4];
        tr4x4_b8(p[0], p[9], p[18], p[27], o);
#pragma unroll
        for (int j = 0; j < 4; ++j) out[j][blk] = o[j]; }
#pragma unroll
    for (int j = 0; j < 4; ++j) __builtin_nontemporal_store((u32x4){out[j][0], out[j][1], out[j][2], out[j][3]}, (u32x4*)(WT + (size_t)rm(c0 + 4 * ng + j) * K + k0 + 16 * c));
    LDS_WAIT(); asm volatile("" ::: "memory");
}
template <bool Q8, class RowMap>
__device__ __forceinline__ void transpose_item(const float* W, int ldw, int k0, int c0, void* WT, int K, const RowMap& rm, const float* kscale, float mul, LAS float* scr, int lane) {
    f32x4 v[16]; titem_load(v, W, ldw, k0, c0, lane); titem_store<Q8>(v, k0, c0, WT, K, rm, kscale, mul, scr, lane);
}
struct RowId { __device__ __forceinline__ int operator()(int n) const { return n; } };
struct RowGU { __device__ __forceinline__ int operator()(int n) const { const int lin = n >= DFF, f = lin ? n - DFF : n; return (f >> 7) * 256 + lin * 128 + (f & 127); } };

__device__ __forceinline__ void norm_row_f16(const float* xrow, const float* gain, f16* orow, int lane, float (&xn)[32]) {
    float s = 0.f;
#pragma unroll
    for (int j = 0; j < 4; ++j) { const f32x4 a = *(const f32x4*)(xrow + 8 * (lane + 64 * j)), b = *(const f32x4*)(xrow + 8 * (lane + 64 * j) + 4);
#pragma unroll
        for (int i = 0; i < 4; ++i) { xn[8 * j + i] = a[i]; xn[8 * j + 4 + i] = b[i]; s += a[i] * a[i] + b[i] * b[i]; } }
    const float rs = 1.0f / sqrtf(wave_sum(s) * (1.0f / DM) + EPS);
#pragma unroll
    for (int j = 0; j < 4; ++j) { const f32x4 ga = *(const f32x4*)(gain + 8 * (lane + 64 * j)), gb = *(const f32x4*)(gain + 8 * (lane + 64 * j) + 4);
#pragma unroll
        for (int i = 0; i < 4; ++i) { xn[8 * j + i] *= rs * ga[i]; xn[8 * j + 4 + i] *= rs * gb[i]; }
        *(f16x8*)(orow + 8 * (lane + 64 * j)) = pack8h((f32x4){xn[8 * j], xn[8 * j + 1], xn[8 * j + 2], xn[8 * j + 3]}, (f32x4){xn[8 * j + 4], xn[8 * j + 5], xn[8 * j + 6], xn[8 * j + 7]}); }
}

__device__ __forceinline__ void ssm_tables(int g, int part, const float* lam_re, const float* lam_im, const float* log_step, const float* b_re, const float* b_im, const float* c_re, const float* c_im,
                                           const float* d_skip, f16* KT, f16* MIN, f16* MOUT, float* L64, LAS unsigned char* lds, int tid) {
    constexpr int PWS = 65, CBS = 80;
    LAS f32x2* Pw = (LAS f32x2*)lds;
    LAS f32x2* Bb = Pw + 65 * PWS;
    LAS f32x2* Cc = Bb + 64 * 16;
    LAS f32x2* Cf = Cc + 16 * 64;
    LAS float* CB = (LAS float*)(Cf + 64);
    const double dt = exp((double)log_step[g]);
    if (tid < 64) { const int p = tid; const double lr = lam_re[g * 64 + p], li = lam_im[g * 64 + p];
        const double mag = exp(lr * dt), br = mag * cos(li * dt), bi = mag * sin(li * dt);
        double pr = 1.0, pi = 0.0;
        for (int j = 0; j <= 64; ++j) { Pw[j * PWS + p] = (f32x2){(float)pr, (float)pi}; const double nr = pr * br - pi * bi, ni = pr * bi + pi * br; pr = nr; pi = ni; }
        const double nr = br - 1.0, ni = bi, den = lr * lr + li * li;
        Cf[p] = (f32x2){(float)((nr * lr + ni * li) / den), (float)((ni * lr - nr * li) / den)}; }
    __syncthreads();
    for (int i = tid; i < 64 * 16; i += 512) { const int p = i >> 4; const f32x2 cf = Cf[p];
        const float br = b_re[(size_t)g * 1024 + i], bi = b_im[(size_t)g * 1024 + i];
        Bb[i] = (f32x2){cf[0] * br - cf[1] * bi, cf[0] * bi + cf[1] * br}; }
    for (int i = tid; i < 16 * 64; i += 512) Cc[i] = (f32x2){c_re[(size_t)g * 1024 + i], c_im[(size_t)g * 1024 + i]};
    __syncthreads();
    f16* KTg = KT + (size_t)g * (65 * 256);
    for (int i = tid; i < 64 * 64; i += 512) { const int p = i >> 6, c = i & 63, cg = 64 * part + c; const f32x2 B = Bb[p * 16 + (cg & 15)], C = Cc[(cg >> 4) * 64 + p];
        CB[(2 * p) * CBS + c] = C[0] * B[0] - C[1] * B[1]; CB[(2 * p + 1) * CBS + c] = -(C[0] * B[1] + C[1] * B[0]); }
    if (tid < 64) KTg[64 * part + tid] = (f16)0.f;
    __syncthreads();
    { const int lane = tid & 63, wv = tid >> 6, l16 = lane & 15, kq = lane >> 4; const LAS float* Pf = (const LAS float*)Pw;
#pragma unroll
      for (int q = 0; q < 2; ++q) { const int mt = (2 * wv + q) >> 2, nt = (2 * wv + q) & 3; f32x4 acc = {0.f, 0.f, 0.f, 0.f};
          const LAS float* ap = Pf + (16 * mt + l16) * (2 * PWS) + kq; const LAS float* bp = CB + kq * CBS + 16 * nt + l16;
#pragma unroll 8
          for (int ks = 0; ks < 32; ++ks) acc = __builtin_amdgcn_mfma_f32_16x16x4f32(ap[4 * ks], bp[4 * ks * CBS], acc, 0, 0, 0);
          const int cg = 64 * part + 16 * nt + l16;
#pragma unroll
          for (int r = 0; r < 4; ++r) { const int j = 16 * mt + 4 * kq + r; float v = acc[r];
              if (j == 0 && (cg >> 4) == (cg & 15)) v += d_skip[g * 16 + (cg >> 4)];
              KTg[(j + 1) * 256 + cg] = (f16)v; } } }
    f16* MINg = MIN + (size_t)g * (128 * 1024);
    for (int v = part * 4096 + tid; v < (part + 1) * 4096; v += 512) { const int row = v >> 7, cv = v & 127, ri = row >> 6, p = row & 63, s_ = cv >> 1, h0 = (cv & 1) * 8;
        const f32x2 P = Pw[(63 - s_) * PWS + p]; float o[8];
#pragma unroll
        for (int q = 0; q < 8; ++q) { const f32x2 B = Bb[p * 16 + h0 + q]; o[q] = ri == 0 ? P[0] * B[0] - P[1] * B[1] : P[0] * B[1] + P[1] * B[0]; }
        *(f16x8*)(MINg + (size_t)row * 1024 + cv * 8) = pack8h((f32x4){o[0], o[1], o[2], o[3]}, (f32x4){o[4], o[5], o[6], o[7]}); }
    f16* MOUTg = MOUT + (size_t)g * (1024 * 128);
    for (int v = part * 4096 + tid; v < (part + 1) * 4096; v += 512) { const int row = v >> 4, cv = v & 15, t = row >> 4, ho = row & 15, ri = cv >> 3, p0 = (cv & 7) * 8; float o[8];
#pragma unroll
        for (int q = 0; q < 8; ++q) { const f32x2 P = Pw[(t + 1) * PWS + p0 + q], C = Cc[ho * 64 + p0 + q]; o[q] = ri == 0 ? C[0] * P[0] - C[1] * P[1] : -(C[0] * P[1] + C[1] * P[0]); }
        *(f16x8*)(MOUTg + (size_t)row * 128 + cv * 8) = pack8h((f32x4){o[0], o[1], o[2], o[3]}, (f32x4){o[4], o[5], o[6], o[7]}); }
    if (part == 0 && tid < 64) *(f32x2*)(L64 + (size_t)(g * 64 + tid) * 2) = Pw[64 * PWS + tid];
    __syncthreads();
}

__device__ __forceinline__ void cumsum_unit(int bh, const float* FL, float* CNEG, LAS unsigned char* lds, int tid) {
    const int b = bh >> 3, h = bh & 7; LAS float* tot = (LAS float*)lds;
    float v[16]; float run = 0.f;
#pragma unroll
    for (int i = 0; i < 16; ++i) { const float x = FL[((size_t)b * SEQ + 16 * tid + i) * 8 + h];
        const float ls = fminf(x, 0.f) - log1pf(__expf(-fabsf(x))); run += ls; v[i] = run; }
    tot[tid] = run; __syncthreads();
    for (int off = 1; off < 512; off <<= 1) { const float a = tid >= off ? tot[tid - off] : 0.f; __syncthreads(); tot[tid] += a; __syncthreads(); }
    const float base = tid > 0 ? tot[tid - 1] : 0.f;
#pragma unroll
    for (int i = 0; i < 16; ++i) CNEG[(size_t)bh * SEQ + 16 * tid + i] = -(base + v[i]) * 11.313708498984761f;
    __syncthreads();
}

struct RouteRec { int e, slot; float gate; int pad; };
__device__ __forceinline__ void router_task(int task, int half, LAS float* pl, const f16* H2, const float* ss_h2, const float* g_moe, const f16* WR, const float* b_router,
                                            unsigned char* X2N, RouteRec* ROUTE, int* ROWTOK, unsigned* cnt, LAS float* lg, int lane, bool commit = true) {
    const int n16 = lane & 15, kq = lane >> 4, tok = task * 16 + n16;
    const float rs = 1.0f / sqrtf(epi::ss_quad<32>(ss_h2 + (size_t)tok * 32, kq) * (1.0f / DM) + EPS);
    f32x4 acc0 = {0.f, 0.f, 0.f, 0.f}, acc1 = {0.f, 0.f, 0.f, 0.f};
    const f16* hrow = H2 + (size_t)tok * DM + 8 * kq; unsigned char* xrow = X2N + (size_t)tok * DM + 8 * kq;
    const f16* w0 = WR + (size_t)n16 * DM + 8 * kq; const f16* w1 = w0 + (size_t)16 * DM;
#pragma unroll 8
    for (int ks = 32 * half; ks < 32 * half + 32; ++ks) {
        const f16x8 hv = *(const f16x8*)(hrow + ks * 32);
        const f32x4 a = {(float)hv[0], (float)hv[1], (float)hv[2], (float)hv[3]}, b = {(float)hv[4], (float)hv[5], (float)hv[6], (float)hv[7]};
        const f32x4 ga = *(const f32x4*)(g_moe + ks * 32 + 8 * kq), gb = *(const f32x4*)(g_moe + ks * 32 + 8 * kq + 4);
        const f32x4 xa = a * ga * rs, xb = b * gb * rs;
        const f16x8 xh = pack8h(xa, xb);
        *(u32x2*)(xrow + ks * 32) = pack8q(xa, xb);
        const f16x8 b0 = *(const f16x8*)(w0 + ks * 32), b1 = *(const f16x8*)(w1 + ks * 32);
        acc0 = __builtin_amdgcn_mfma_f32_16x16x32_f16(xh, b0, acc0, 0, 0, 0);
        acc1 = __builtin_amdgcn_mfma_f32_16x16x32_f16(xh, b1, acc1, 0, 0, 0);
    }
    if (half == 1) { *(LAS f32x4*)(pl + lane * 8) = acc0; *(LAS f32x4*)(pl + lane * 8 + 4) = acc1; }
    __syncthreads();
    if (half == 0) { acc0 = acc0 + *(const LAS f32x4*)(pl + lane * 8); acc1 = acc1 + *(const LAS f32x4*)(pl + lane * 8 + 4);
#pragma unroll
        for (int r = 0; r < 4; ++r) { lg[(4 * kq + r) * 33 + n16] = acc0[r]; lg[(4 * kq + r) * 33 + 16 + n16] = acc1[r]; } }
    LDS_WAIT(); asm volatile("" ::: "memory");
    if (lane < 16 && commit && half == 0) {
        float v[NE];
#pragma unroll
        for (int e = 0; e < NE; ++e) v[e] = lg[lane * 33 + e] + b_router[e];
        float tv[TOPK]; int te[TOPK];
#pragma unroll
        for (int j = 0; j < TOPK; ++j) { float best = -__builtin_inff(); int bi = 0;
#pragma unroll
            for (int e = 0; e < NE; ++e) { const bool gt = v[e] > best; best = gt ? v[e] : best; bi = gt ? e : bi; }
            tv[j] = best; te[j] = bi;
#pragma unroll
            for (int e = 0; e < NE; ++e) v[e] = (e == bi) ? -__builtin_inff() : v[e]; }
        float ex[TOPK], sum = 0.f;
#pragma unroll
        for (int j = 0; j < TOPK; ++j) { ex[j] = __expf(tv[j] - tv[0]); sum += ex[j]; }
        const float inv = 1.0f / sum; const int t = task * 16 + lane;
#pragma unroll
        for (int j = 0; j < TOPK; ++j) { const int slot = (int)atomicAdd(cnt + te[j] * CNT_STRIDE, 1u);
            ROWTOK[(size_t)te[j] * M + slot] = t;
            RouteRec rr; rr.e = te[j]; rr.slot = slot; rr.gate = ex[j] * inv; rr.pad = 0; ROUTE[(size_t)t * TOPK + j] = rr; }
    }
    LDS_WAIT(); asm volatile("" ::: "memory");
}

__device__ __forceinline__ void moe_table(const unsigned* cnt, LAS int* tab, int tid) {
    __syncthreads();
    if (tid == 0) { int run = 0;
        for (int e = 0; e < NE; ++e) { const int c = (int)cnt[e * CNT_STRIDE]; tab[e] = run; tab[64 + e] = c; run += (c + 255) >> 8; }
        tab[32] = run; }
    __syncthreads();
}

__device__ __forceinline__ void final_row(int tok, const f16* H2, const unsigned char* YS, const RouteRec* ROUTE, const LAS int* tab, const float* g_final, float* out, int lane) {
    float v[32];
#pragma unroll
    for (int j = 0; j < 4; ++j) { const f16x8 hv = *(const f16x8*)(H2 + (size_t)tok * DM + 8 * (lane + 64 * j));
#pragma unroll
        for (int i = 0; i < 8; ++i) v[8 * j + i] = (float)hv[i]; }
#pragma unroll
    for (int q = 0; q < TOPK; ++q) { const RouteRec rr = ROUTE[(size_t)tok * TOPK + q]; const size_t row = (size_t)tab[rr.e] * 256 + rr.slot;
#pragma unroll
        for (int j = 0; j < 4; ++j) { const u32x2 y = *(const u32x2*)(YS + row * DM + 8 * (lane + 64 * j));
            const f32x2 y0 = __builtin_amdgcn_cvt_pk_f32_fp8(y[0], false), y1 = __builtin_amdgcn_cvt_pk_f32_fp8(y[0], true), y2 = __builtin_amdgcn_cvt_pk_f32_fp8(y[1], false), y3 = __builtin_amdgcn_cvt_pk_f32_fp8(y[1], true);
            v[8 * j + 0] += rr.gate * y0[0]; v[8 * j + 1] += rr.gate * y0[1]; v[8 * j + 2] += rr.gate * y1[0]; v[8 * j + 3] += rr.gate * y1[1];
            v[8 * j + 4] += rr.gate * y2[0]; v[8 * j + 5] += rr.gate * y2[1]; v[8 * j + 6] += rr.gate * y3[0]; v[8 * j + 7] += rr.gate * y3[1]; } }
    float s = 0.f;
#pragma unroll
    for (int i = 0; i < 32; ++i) s += v[i] * v[i];
    const float rs = 1.0f / sqrtf(wave_sum(s) * (1.0f / DM) + EPS);
#pragma unroll
    for (int j = 0; j < 4; ++j) { const f32x4 ga = *(const f32x4*)(g_final + 8 * (lane + 64 * j)), gb = *(const f32x4*)(g_final + 8 * (lane + 64 * j) + 4);
        f32x4 oa, ob;
#pragma unroll
        for (int i = 0; i < 4; ++i) { oa[i] = v[8 * j + i] * rs * ga[i]; ob[i] = v[8 * j + 4 + i] * rs * gb[i]; }
        *(f32x4*)(out + (size_t)tok * DM + 8 * (lane + 64 * j)) = oa; *(f32x4*)(out + (size_t)tok * DM + 8 * (lane + 64 * j) + 4) = ob; }
}

#ifndef MK_N_LAUNCHES
#define MK_N_LAUNCHES 1
#endif
constexpr int N_PHASES = 12;
struct Args { const float* in[31]; float* out; unsigned char* ws; int ph_lo, ph_hi, li, pad; };
static_assert(sizeof(Args) == 280 && __builtin_offsetof(Args, out) == 248 && __builtin_offsetof(Args, ws) == 256, "kernarg layout used by INP/OUTP/PHASE_WS");
enum { I_X = 0, I_MEM, I_GMIX, I_WIN, I_BF, I_LRE, I_LIM, I_LSTEP, I_BRE, I_BIM, I_CRE, I_CIM, I_DSKIP, I_WGLU, I_BGLU, I_GATT, I_GSSM, I_WOUT, I_GCROSS, I_GMEM,
       I_WCQ, I_WCKV, I_WCO, I_GMOE, I_WR, I_BR, I_WGU, I_BGU, I_WDN, I_BDN, I_GFINAL };

__global__ void __launch_bounds__(NWAVES * 64, 2) fwd(Args args) {
    extern __shared__ __attribute__((aligned(16))) unsigned char lds_raw[];
    LAS unsigned char* const lds = (LAS unsigned char*)lds_raw;
    const int G = gridDim.x, bx = blockIdx.x, vcu = (G % 8 == 0) ? (bx % 8) * (G / 8) + bx / 8 : bx;
    { const int t0 = threadIdx.x; for (int u = t0; u < (LDS_BYTES - MISC_OFF) / 4; u += NWAVES * 64) ((LAS unsigned*)(lds + MISC_OFF))[u] = 0u; }
    __syncthreads();
#ifndef PHASE_MASK
#define PHASE_MASK 0xFFF
#endif
    const int lo = args.ph_lo, hi = args.ph_hi;
    const bool IN2_ = ((PHASE_MASK >> 2) & 1) && lo <= 2 && 2 < hi;
    XcdBarrier bar; bar.bar = (unsigned*)(args.ws + WS_CTL) + CW_BAR + args.li * XCD_BAR_WORDS; bar.x = 0; bar.st = nullptr; bar.gexp = 0u;
    if (hi - lo > 1) bar = xcd_barrier_post((unsigned*)(args.ws + WS_CTL) + CW_BAR + args.li * XCD_BAR_WORDS, (volatile LAS unsigned*)(lds + MISC_OFF));
    const bool fuse23 = IN2_ && (G % 16 == 0);
    XcdBarrier bar2 = bar;
    if (fuse23 && (vcu & 1) == 0) bar2 = xcd_barrier_post((unsigned*)(args.ws + WS_CTL) + CW_BAR + 3 * XCD_BAR_WORDS, (volatile LAS unsigned*)(lds + MISC_OFF + 8), (unsigned)(G / 2));
#define IN(k) (((PHASE_MASK >> (k)) & 1) && lo <= (k) && (k) < hi)
#define SEAM(k) do { if (IN(k) && IN((k) + 1)) xcd_barrier(bar); } while (0)
#define SEAM2(k, k2) do { if (IN(k) && IN(k2)) xcd_barrier(bar); } while (0)
#ifndef REPEAT_PHASE
#define REPEAT_PHASE -1
#endif
#define REP(k) for (int rep_ = 0; rep_ < ((k) == REPEAT_PHASE ? 2 : 1); (void)(++rep_), __syncthreads())
#define WSP(T, off) ((T*)(wsb + (off)))
typedef const unsigned char __attribute__((address_space(4)))* kaptr_t;
#define PHASE_WS() kaptr_t kab = (kaptr_t)__builtin_amdgcn_kernarg_segment_ptr(); asm volatile("" : "+s"(kab)); \
        GAS unsigned char* wsg_ = *(GAS unsigned char* const __attribute__((address_space(4)))*)(kab + 256); asm volatile("" : "+s"(wsg_)); unsigned char* wsb = (unsigned char*)wsg_
#define INP(i) ((const float*)*(GAS const float* const __attribute__((address_space(4)))*)(kab + 8 * (i)))
#define OUTP() ((float*)*(GAS float* const __attribute__((address_space(4)))*)(kab + 248))
#define SUB_WS() do { asm volatile("" : "+s"(wsg_)); wsb = (unsigned char*)wsg_; } while (0)
#define TIDS() const int tid = opaque_tid(), lane = tid & 63, wave = __builtin_amdgcn_readfirstlane(tid >> 6), gw = vcu * NWAVES + wave, NGW = G * NWAVES; (void)lane; (void)gw; (void)NGW

    REP(0) if (IN(0)) { PHASE_WS();
#ifndef P0A_REP
#define P0A_REP 1
#endif
#ifndef P0B_REP
#define P0B_REP 1
#endif
#pragma unroll 1
        for (int st_ = 0; st_ < 2; ++st_) {
        if ((st_ == 0) == ((vcu & 1) == 0)) {
        for (int r4 = 0; r4 < P0A_REP; ++r4)
        { TIDS();
          ssm_tables(vcu >> 2, vcu & 3, INP(I_LRE), INP(I_LIM), INP(I_LSTEP), INP(I_BRE), INP(I_BIM), INP(I_CRE), INP(I_CIM), INP(I_DSKIP),
                                   WSP(f16, WS_KT), WSP(f16, WS_MIN), WSP(f16, WS_MOUT), WSP(float, WS_L64), lds, tid); }
        } else {
        for (int r4 = 0; r4 < P0B_REP; ++r4)
        {
            TIDS();
            LAS float* wf = (LAS float*)lds; const float* w_in = INP(I_WIN);
            for (int i = tid; i < DM * 8; i += NWAVES * 64) wf[i + (i >> 6) * 4] = w_in[(size_t)(i >> 3) * INC + 4 * AW + (i & 7)];
            __syncthreads();
            f16* XN = WSP(f16, WS_XN); float* FL = WSP(float, WS_FL);
            {   f32x4 nx[8]; const float* xin = INP(I_X);
#pragma unroll
                for (int j = 0; j < 4; ++j) { nx[2 * j] = *(const f32x4*)(xin + (size_t)gw * DM + 8 * (lane + 64 * j)); nx[2 * j + 1] = *(const f32x4*)(xin + (size_t)gw * DM + 8 * (lane + 64 * j) + 4); }
#pragma unroll 1
                for (int m = gw; m < M; m += NGW) {
                    f32x4 cx[8];
#pragma unroll
                    for (int q = 0; q < 8; ++q) cx[q] = nx[q];
                    const int mn = (m + NGW < M) ? m + NGW : m;
#pragma unroll
                    for (int j = 0; j < 4; ++j) { nx[2 * j] = *(const f32x4*)(xin + (size_t)mn * DM + 8 * (lane + 64 * j)); nx[2 * j + 1] = *(const f32x4*)(xin + (size_t)mn * DM + 8 * (lane + 64 * j) + 4); }
                    float sq = 0.f;
#pragma unroll
                    for (int j = 0; j < 4; ++j)
#pragma unroll
                        for (int i = 0; i < 4; ++i) sq += cx[2 * j][i] * cx[2 * j][i] + cx[2 * j + 1][i] * cx[2 * j + 1][i];
                    const float rs = 1.0f / sqrtf(wave_sum(sq) * (1.0f / DM) + EPS);
#pragma unroll
                    for (int j = 0; j < 4; ++j) { const f32x4 ga = *(const f32x4*)(INP(I_GMIX) + 8 * (lane + 64 * j)), gb = *(const f32x4*)(INP(I_GMIX) + 8 * (lane + 64 * j) + 4);
                        cx[2 * j] = cx[2 * j] * (ga * rs); cx[2 * j + 1] = cx[2 * j + 1] * (gb * rs);
                        *(f16x8*)(XN + (size_t)m * DM + 8 * (lane + 64 * j)) = pack8h(cx[2 * j], cx[2 * j + 1]); }
                    float fl[8] = {0.f, 0.f, 0.f, 0.f, 0.f, 0.f, 0.f, 0.f};
#pragma unroll
                    for (int j = 0; j < 4; ++j) {
#pragma unroll
                        for (int i = 0; i < 8; ++i) { const int k = 8 * (lane + 64 * j) + i; const f32x4 wa = *(const LAS f32x4*)(wf + k * 8 + (lane + 64 * j) * 4), wb = *(const LAS f32x4*)(wf + k * 8 + (lane + 64 * j) * 4 + 4);
                            const float xv = cx[2 * j + (i >> 2)][i & 3];
#pragma unroll
                            for (int h = 0; h < 4; ++h) { fl[h] += xv * wa[h]; fl[4 + h] += xv * wb[h]; } }
                        __builtin_amdgcn_sched_barrier(0); }
#pragma unroll
                    for (int h = 0; h < 8; ++h) fl[h] = wave_sum(fl[h]);
                    if (lane < 8) { float v = fl[0];
#pragma unroll
                        for (int h = 1; h < 8; ++h) v = (lane == h) ? fl[h] : v;
                        FL[(size_t)m * 8 + lane] = v + INP(I_BF)[lane]; }
                }
            }
            f16* MEMN = WSP(f16, WS_MEMN);
            for (int m = gw; m < BATCH * MEML; m += NGW) { float xn[32]; norm_row_f16(INP(I_MEM) + (size_t)m * DM, INP(I_GMEM), MEMN + (size_t)m * DM, lane, xn); }
            {
                const float* wq = INP(I_WCQ); const float* gc = INP(I_GCROSS); f16* WCQS = WSP(f16, WS_WCQ);
                for (int v = gw * 64 + lane; v < DM * DM / 8; v += NGW * 64) { const float sc = gc[v >> 8] * 0.04419417382415922f;
                    const f32x4 a = *(const f32x4*)(wq + (size_t)v * 8), b = *(const f32x4*)(wq + (size_t)v * 8 + 4);
                    *(f16x8*)(WCQS + (size_t)v * 8) = pack8h(a * sc, b * sc); } }
            f16* WRT = WSP(f16, WS_WR);
            for (int i = gw * 64 + lane; i < NE * DM; i += NGW * 64) { const int e = i / DM, k = i % DM; WRT[i] = (f16)INP(I_WR)[(size_t)k * NE + e]; }
            __syncthreads();
        }
        {
            TIDS();
            LAS float* scr = (LAS float*)(lds + wave * (64 * 65 * 4));
            constexpr int I_IN = 32 * 64, I_GL = 16 * 16, I_OU = 32 * 32, I_KV = 32 * 64, I_CO = 32 * 32;
            constexpr int NITEMS = I_IN + I_GL + I_OU + I_KV + I_CO;
            const RowId rid;
            for (int it = gw; it < NITEMS; it += NGW) {
                int r = it;
                if (r < I_IN) { transpose_item<false>(INP(I_WIN), INC, 64 * (r / 64), 64 * (r % 64), WSP(f16, WS_WIN), DM, rid, nullptr, 1.0f, scr, lane); continue; } r -= I_IN;
                if (r < I_GL) { transpose_item<false>(INP(I_WGLU), SSMW, 64 * (r / 16), 64 * (r % 16), WSP(f16, WS_WGLU), SSMW, rid, nullptr, 1.0f, scr, lane); continue; } r -= I_GL;
                if (r < I_OU) { const int kb = r / 32; const float* ksc = kb < 16 ? INP(I_GATT) : INP(I_GSSM) - AW;
                    transpose_item<false>(INP(I_WOUT), DM, 64 * kb, 64 * (r % 32), WSP(f16, WS_WOUT), DM, rid, ksc, 1.0f, scr, lane); continue; } r -= I_OU;
                if (r < I_KV) { transpose_item<false>(INP(I_WCKV), 2 * DM, 64 * (r / 64), 64 * (r % 64), WSP(f16, WS_WCKV), DM, rid, nullptr, 1.0f, scr, lane); continue; } r -= I_KV;
                transpose_item<false>(INP(I_WCO), DM, 64 * (r / 32), 64 * (r % 32), WSP(f16, WS_WCO), DM, rid, nullptr, 1.0f, scr, lane);
            }
        }
        }
        __syncthreads();
        SUB_WS();
        }
    }
    SEAM(0);
    REP(1) if (IN(1)) { PHASE_WS();
        if (vcu < BATCH * AH) { TIDS(); cumsum_unit(vcu, WSP(float, WS_FL), WSP(float, WS_CNEG), lds, tid); }
        pg8::DenseOrder S; S.init(WSP(f16, WS_XN), WSP(f16, WS_WIN), M, 4 * AW, DM, G, bx);
        epi::InProj E{WSP(f16, WS_U), WSP(f16, WS_Q), (size_t)(WS_K - WS_Q) / 2, (int*)(wsb + WS_CTL) + CW_KMAX};
        pg8::gemm_phase<epi::InProj, pg8::DenseOrder>(lds, DM * 2, S, E);
    }
    SEAM(1);
#ifndef P2A_REP
#define P2A_REP 1
#endif
#ifndef P2B_REP
#define P2B_REP 1
#endif
    REP(2) if (IN(2)) { PHASE_WS();
        if ((vcu & 1) == 0) {
            const int w = vcu >> 1;
#pragma unroll 1
            for (int q = 0; q < 2 * P2A_REP; ++q) { const int id = 2 * w + (q & 1);
                fox::item(id >> 4, id & 15, WSP(f16, WS_Q), WSP(f16, WS_K), WSP(f16, WS_V), WSP(f16, WS_MIX), WSP(float, WS_SSATT), WSP(float, WS_CNEG), (const float*)(wsb + WS_CTL) + CW_KMAX, (char*)lds_raw); }
            SUB_WS();
#pragma unroll 1
            for (int q = 0; q < 2 * P2B_REP; ++q) { const int id = (q & 1) == 0 ? w : 255 - w;
                ssm::unit((id >> 1) >> 6, (id >> 1) & 63, id & 1, WSP(f16, WS_U), WSP(f16, WS_KT), WSP(f16, WS_MIN), WSP(f16, WS_MOUT), WSP(float, WS_L64), WSP(f16, WS_G), lds); }
            SUB_WS();
            {
                pg8::DenseOrder S; S.init(WSP(f16, WS_MEMN), WSP(f16, WS_WCKV), BATCH * MEML, 2 * DM, DM, G, (w & 7) < 2 ? 2 * (w >> 3) + (w & 7) : (1 << 20));
                epi::PlainF16 E{WSP(f16, WS_KVC), 2 * DM};
                pg8::gemm_phase<epi::PlainF16, pg8::DenseOrder>(lds, DM * 2, S, E);
            }
            if (fuse23) {
                xcd_barrier(bar2);
                SUB_WS();
                const int c2 = (bx & 7) + 8 * ((bx >> 3) >> 1);
                {   pg8::DenseOrder S; S.init(WSP(f16, WS_G), WSP(f16, WS_WGLU), M, SSMW, SSMW, G / 2, c2);
                    epi::Glu E{WSP(f16, WS_G), INP(I_BGLU), WSP(f16, WS_MIX), WSP(float, WS_SSSSM)};
                    pg8::gemm_phase<epi::Glu, pg8::DenseOrder>(lds, SSMW * 2, S, E); }
                SUB_WS();
                {   epi::CrossPreOut EP{WSP(unsigned char, WS_WKT), WSP(unsigned char, WS_VWT)};
                    pg8::CrossPre<0> S0{WSP(f16, WS_KVC), WSP(f16, WS_WCQ), c2 < 64 ? c2 : -1};
                    pg8::gemm_phase<epi::CrossPreOut, pg8::CrossPre<0>>(lds, CD * 2, S0, EP);
                    pg8::CrossPre<1> S1{WSP(f16, WS_KVC), WSP(f16, WS_WCO), (c2 >= 64 && c2 < 128) ? c2 - 64 : -1};
                    pg8::gemm_phase<epi::CrossPreOut, pg8::CrossPre<1>>(lds, CD * 2, S1, EP); }
            }
        }
        SUB_WS();
        {
            TIDS();
            LAS float* scr = (LAS float*)(lds + wave * (128 * 33 * 4));
            constexpr int I_GU = NE * 16 * 128, I_DN = NE * 16 * 64, NI = I_GU + I_DN, CH = 8;
            const RowId rid; const RowGU rgu;
#ifndef P2C_REP
#define P2C_REP 1
#endif
#pragma unroll 1
            for (int r3 = 0; r3 < P2C_REP; ++r3) {
            unsigned* claim = (unsigned*)(wsb + WS_CTL) + CW_CLAIM + 64 * r3;
#define XI_LOAD(v, it) do { int r_ = (it); if (r_ < I_GU) { const int e = r_ / 2048, q = r_ % 2048; qitem_load(v, INP(I_WGU) + (size_t)e * DM * 2 * DFF, 2 * DFF, 128 * (q / 128), 32 * (q % 128), lane); } \
        else { r_ -= I_GU; const int e = r_ / 1024, q = r_ % 1024; qitem_load(v, INP(I_WDN) + (size_t)e * DFF * DM, DM, 128 * (q / 64), 32 * (q % 64), lane); } } while (0)
#define XI_STORE(v, it) do { int r_ = (it); if (r_ < I_GU) { const int e = r_ / 2048, q = r_ % 2048; qitem_store(v, 128 * (q / 128), 32 * (q % 128), WSP(unsigned char, WS_WGU) + (size_t)e * 2 * DFF * DM, DM, rgu, WQ_SCALE, scr, lane); } \
        else { r_ -= I_GU; const int e = r_ / 1024, q = r_ % 1024; qitem_store(v, 128 * (q / 64), 32 * (q % 64), WSP(unsigned char, WS_WDN) + (size_t)e * DM * DFF, DFF, rid, WQ_SCALE, scr, lane); } } while (0)
            volatile LAS int* cw = (volatile LAS int*)(lds + MISC_OFF + 32);
#define XI_NEXT(dst, par) do { if (tid == 0) cw[par] = (int)atomicAdd(claim, 1u) * CH; __syncthreads(); dst = cw[par] + wave; } while (0)
            int ia, ib;
            f32x4 va[16], vb[16];
            XI_NEXT(ia, 0); if (ia < NI) XI_LOAD(va, ia);
            while (ia < NI) {
                XI_NEXT(ib, 1); if (ib < NI) XI_LOAD(vb, ib);
                XI_STORE(va, ia); if (ib >= NI) break;
                XI_NEXT(ia, 0); if (ia < NI) XI_LOAD(va, ia);
                XI_STORE(vb, ib);
            }
            __syncthreads();
            }
#undef XI_LOAD
#undef XI_STORE
#undef XI_NEXT
        }
    }
    SEAM2(2, 4);
#ifndef EXTRA_BARS
#define EXTRA_BARS 0
#endif
    if (hi - lo > 1) for (int xb_ = 0; xb_ < EXTRA_BARS; ++xb_) xcd_barrier(bar);
    REP(4) if (IN(4)) { PHASE_WS();
        pg8::DenseOrder S; S.init(WSP(f16, WS_MIX), WSP(f16, WS_WOUT), M, DM, DM, G, bx);
        epi::OutProj E{INP(I_X), WSP(f16, WS_HA), WSP(float, WS_SSATT), WSP(float, WS_SSSSM), WSP(float, WS_SSH), WSP(unsigned char, WS_H8)};
        pg8::gemm_phase<epi::OutProj, pg8::DenseOrder, true>(lds, DM * 2, S, E, (LAS float*)(lds + MSC_OFF));
    }
    SEAM(4);
    REP(5) if (IN(5)) { PHASE_WS();
        pg8::DenseOrder S; S.init(WSP(f16, WS_H8), WSP(f16, WS_WKT), M, CH * MEML, DM / 2, G, bx, (size_t)CH * MEML * DM);
        epi::CrossSoftmax E{WSP(unsigned char, WS_PB), WSP(float, WS_SSH), (LAS float*)(lds + XCH_OFF)};
        pg8::gemm_phase<epi::CrossSoftmax, pg8::DenseOrder, false, true>(lds, DM, S, E);
    }
    SEAM(5);
    REP(7) if (IN(7)) { PHASE_WS();
        pg8::DenseOrder S; S.init(WSP(f16, WS_PB), WSP(f16, WS_VWT), M, DM, CH * MEML / 2, G, bx, (size_t)DM * CH * MEML);
        epi::CrossO E{WSP(f16, WS_HA), WSP(float, WS_SSH2)};
        pg8::gemm_phase<epi::CrossO, pg8::DenseOrder, false, true>(lds, CH * MEML, S, E);
    }
    SEAM(7);
    REP(8) if (IN(8)) { PHASE_WS();
        TIDS();
        LAS float* lg = (LAS float*)(lds + wave * (16 * 33 * 4));
#ifndef P8_REP
#define P8_REP 1
#endif
        for (int r5 = 0; r5 < P8_REP; ++r5)
        { const int t = (wave & 3) * G + vcu;
          router_task(t < M / 16 ? t : 0, wave >> 2, (LAS float*)(lds + NWAVES * 16 * 33 * 4) + (wave & 3) * 512, WSP(f16, WS_HA), WSP(float, WS_SSH2), INP(I_GMOE), WSP(f16, WS_WR), INP(I_BR), WSP(unsigned char, WS_X2N), WSP(RouteRec, WS_ROUTE), WSP(int, WS_ROWTOK),
                                                           (unsigned*)(wsb + WS_CTL) + CW_CNT, lg, lane, r5 == P8_REP - 1 && t < M / 16); }
    }
    SEAM(8);
    REP(9) if (IN(9)) { PHASE_WS();
        { TIDS(); moe_table((unsigned*)(wsb + WS_CTL) + CW_CNT, (LAS int*)(lds + MOE_TAB_OFF), tid); }
        MoeOrder<true> S{(LAS int*)(lds + MOE_TAB_OFF), (const char*)WSP(char, WS_X2N), (const char*)WSP(char, WS_WGU), WSP(int, WS_ROWTOK), (size_t)2 * DFF * DM, DM, 16, G, bx};
        epi::ExpertGU E{WSP(unsigned char, WS_ACT), INP(I_BGU)};
        pg8::gemm_phase<epi::ExpertGU, MoeOrder<true>, false, true>(lds, DM, S, E);
    }
    SEAM(9);
    REP(10) if (IN(10)) { PHASE_WS();
        if (!IN(9)) { TIDS(); moe_table((unsigned*)(wsb + WS_CTL) + CW_CNT, (LAS int*)(lds + MOE_TAB_OFF), tid); }
        MoeOrder<false> S{(LAS int*)(lds + MOE_TAB_OFF), (const char*)WSP(char, WS_ACT), (const char*)WSP(char, WS_WDN), WSP(int, WS_ROWTOK), (size_t)DM * DFF, DFF, 8, G, bx};
        epi::ExpertDown E{WSP(unsigned char, WS_YS), INP(I_BDN)};
        pg8::gemm_phase<epi::ExpertDown, MoeOrder<false>, false, true>(lds, DFF, S, E);
    }
    SEAM(10);
    REP(11) if (IN(11)) { PHASE_WS();
        TIDS();
        if (!IN(9)) moe_table((unsigned*)(wsb + WS_CTL) + CW_CNT, (LAS int*)(lds + MOE_TAB_OFF), tid);
        for (int m = gw; m < M; m += NGW) final_row(m, WSP(f16, WS_HA), WSP(unsigned char, WS_YS), WSP(RouteRec, WS_ROUTE), (const LAS int*)(lds + MOE_TAB_OFF), INP(I_GFINAL), OUTP(), lane);
    }
#undef IN
#undef SEAM
#undef REP
#undef WSP
#undef INP
#undef OUTP
#undef PHASE_WS
#undef SUB_WS
#undef TIDS
}

extern "C" void kernel_launch(void* const* d_in, const int* in_sizes, int n_in, void* d_out, int out_size, void* d_ws, size_t ws_size, hipStream_t stream) {
    static int grid = 0;
    if (grid == 0) {
        if (n_in != 31 || in_sizes[0] != M * DM || out_size != M * DM || ws_size < WS_END) {
            fprintf(stderr, "kernel_launch: built for 31 inputs, x/out of %d floats, >= %zu bytes of workspace; got n_in %d, in0 %d, out %d, ws %zu; nothing launched\n", M * DM, (size_t)WS_END, n_in, n_in > 0 ? in_sizes[0] : -1, out_size, ws_size);
            grid = -1; return; }
        int dev = 0, cus = 0, per_cu = 0;
        if (hipGetDevice(&dev) != hipSuccess || hipDeviceGetAttribute(&cus, hipDeviceAttributeMultiprocessorCount, dev) != hipSuccess) { fprintf(stderr, "kernel_launch: device query failed\n"); grid = -1; return; }
        if (hipFuncSetAttribute((const void*)fwd, hipFuncAttributeMaxDynamicSharedMemorySize, LDS_BYTES) != hipSuccess) { fprintf(stderr, "kernel_launch: hipFuncSetAttribute failed\n"); grid = -1; return; }
        if (hipOccupancyMaxActiveBlocksPerMultiprocessor(&per_cu, (const void*)fwd, NWAVES * 64, LDS_BYTES) != hipSuccess || per_cu < 1)
            fprintf(stderr, "kernel_launch: note: occupancy query reports %d workgroups per CU\n", per_cu);
        (void)hipGetLastError();
        grid = (cus / 16) * 16;
        if (grid != 256) fprintf(stderr, "kernel_launch: %d CUs; the phase program assumes 256\n", grid);
    }
    if (grid < 0) return;
    if (hipMemsetAsync((char*)d_ws + WS_CTL, 0, CTL_ZERO_BYTES, stream) != hipSuccess) { fprintf(stderr, "kernel_launch: memset failed\n"); return; }
    Args a{};
    for (int i = 0; i < 31; ++i) a.in[i] = (const float*)d_in[i];
    a.out = (float*)d_out; a.ws = (unsigned char*)d_ws;
    constexpr int NL = MK_N_LAUNCHES;
    for (int li = 0; li < NL; ++li) {
        a.ph_lo = (NL == 1) ? 0 : li; a.ph_hi = (NL == 1) ? N_PHASES : li + 1; a.li = 0; a.pad = 0;
        hipLaunchKernelGGL(fwd, dim3(grid), dim3(NWAVES * 64), LDS_BYTES, stream, a);
        const hipError_t le = hipPeekAtLastError();
        if (le != hipSuccess) { fprintf(stderr, "kernel_launch: launch %d failed: %s\n", li, hipGetErrorName(le)); break; }
    }
}
```
